# Optimizing an MI355X kernel written in HIP

```python
import jax, jax.numpy as jnp
from jax import lax
import numpy as np

D_MODEL = 1024
BATCH = 8
SEQ = 4096
DEPTH = 1
DEC_BATCH = 32
DEC_SEQ = 16
PAST_LEN = 1024

CHUNK = 64
N_MEM = 256
MEM_HEADS = 4
MEM_HEAD_DIM = D_MODEL // MEM_HEADS
D_POOL = D_MODEL // 2
POOL_WINDOWS = (2, 4, 8, 16)
POOL_GROUPS = len(POOL_WINDOWS)
POOL_GW = D_POOL // POOL_GROUPS
POOL_STATE = max(POOL_WINDOWS) - 1
D_SGU = D_MODEL // 2
SGU_HEADS = 4
SGU_HW = D_SGU // SGU_HEADS
SGU_CHUNK = 128
D_FF = 2816
D_IN = D_POOL + 2 * D_SGU + 2 * D_MODEL
EPS = 1e-6

kernel_name = "hybrid_pool_sgu_streaming_step"


def _rmsnorm(x, g):
    xf = x.astype(jnp.float32)
    y = xf * lax.rsqrt(jnp.mean(xf * xf, axis=-1, keepdims=True) + EPS)
    return (y * g.astype(jnp.float32)).astype(x.dtype)


def _layernorm(x, g):
    xf = x.astype(jnp.float32)
    mu = jnp.mean(xf, axis=-1, keepdims=True)
    xc = xf - mu
    y = xc * lax.rsqrt(jnp.mean(xc * xc, axis=-1, keepdims=True) + EPS)
    return (y * g.astype(jnp.float32)).astype(x.dtype)


def _swiglu(x, w1, w3, w2):
    return (jax.nn.silu(x @ w1) * (x @ w3)) @ w2


def _sgu_mask():
    blk = jnp.arange(SGU_CHUNK) // CHUNK
    return blk[:, None] >= blk[None, :]


def _pool_mixer(xa, prefix, pos0, w_pool, pool_scale):
    B, L, _ = xa.shape
    cat = jnp.concatenate([prefix.astype(xa.dtype), xa], axis=1)
    csum = jnp.cumsum(cat.astype(jnp.float32), axis=1)
    csum = jnp.concatenate([jnp.zeros_like(csum[:, :1]), csum], axis=1)
    end = csum[:, POOL_STATE + 1:]
    pos = pos0 + jnp.arange(L)
    outs = []
    for g, w in enumerate(POOL_WINDOWS):
        sl = slice(g * POOL_GW, (g + 1) * POOL_GW)
        start = csum[:, POOL_STATE + 1 - w: POOL_STATE + 1 - w + L, sl]
        cnt = jnp.minimum(w, pos + 1).astype(jnp.float32)[None, :, None]
        outs.append((end[..., sl] - start) / cnt)
    pooled = jnp.concatenate(outs, axis=-1).astype(xa.dtype)
    d = (pooled - xa).reshape(B, L, POOL_GROUPS, POOL_GW)
    mixed = jnp.einsum('blgc,gcd->blgd', d, w_pool).reshape(B, L, D_POOL)
    return mixed * pool_scale, cat[:, -POOL_STATE:]


def _sgu_prompt(v, w_s, b_s):
    B, L, _ = v.shape
    vb = v.reshape(B, L // SGU_CHUNK, SGU_CHUNK, SGU_HEADS, SGU_HW)
    wm = jnp.where(_sgu_mask()[None], w_s, 0.0).astype(v.dtype)
    z = jnp.einsum('hpq,bnqhc->bnphc', wm, vb) + b_s.T[:, :, None]
    return z.reshape(B, L, D_SGU)


def _sgu_sample(v, w_s, b_s):
    B, T, _ = v.shape
    vb = v.reshape(B, T, SGU_HEADS, SGU_HW)
    wm = jnp.where(_sgu_mask()[None], w_s, 0.0).astype(v.dtype)[:, :T, :T]
    z = jnp.einsum('hpq,bqhc->bphc', wm, vb) + b_s[:, :T].T[:, :, None]
    return z.reshape(B, T, D_SGU)


def _mem_kv(mem, g_mem, w_mk, w_mv):
    B = mem.shape[0]
    mn = _rmsnorm(mem, g_mem)
    k = (mn @ w_mk).reshape(B, N_MEM, MEM_HEADS, MEM_HEAD_DIM)
    v = (mn @ w_mv).reshape(B, N_MEM, MEM_HEADS, MEM_HEAD_DIM)
    return k, v


def _layer(x, mem_k, mem_v, pool_prefix, pos0, is_prompt, p):
    B, L, _ = x.shape
    h = x + 0.5 * _swiglu(_rmsnorm(x, p['g_ff1']), p['w1a'], p['w3a'], p['w2a'])
    n = _rmsnorm(h, p['g_mix'])
    z = n @ p['w_in']
    xa = z[..., :D_POOL]
    uv = jax.nn.gelu(z[..., D_POOL:D_POOL + 2 * D_SGU])
    u, v = uv[..., :D_SGU], uv[..., D_SGU:]
    gate = jax.nn.sigmoid(z[..., D_POOL + 2 * D_SGU:] + p['b_gate'])
    g_a, g_b = gate[..., :D_MODEL], gate[..., D_MODEL:]
    a, pool_state = _pool_mixer(xa, pool_prefix, pos0, p['w_pool'], p['pool_scale'])
    vn = _layernorm(v, p['g_sgu'])
    s = _sgu_prompt(vn, p['w_s'], p['b_s']) if is_prompt else _sgu_sample(vn, p['w_s'], p['b_s'])
    merged = g_a * (a @ p['w_pa']) + g_b * ((u * s) @ p['w_pb'])
    h = h + merged @ p['w_o']
    q = (_rmsnorm(h, p['g_ca']) @ p['w_q']).reshape(B, L, MEM_HEADS, MEM_HEAD_DIM)
    sc = jnp.einsum('blhd,bmhd->bhlm', q, mem_k).astype(jnp.float32) * (MEM_HEAD_DIM ** -0.5)
    pr = jax.nn.softmax(sc, axis=-1).astype(x.dtype)
    o = jnp.einsum('bhlm,bmhd->blhd', pr, mem_v).reshape(B, L, D_MODEL)
    h = h + o @ p['w_co']
    h = h + 0.5 * _swiglu(_rmsnorm(h, p['g_ff2']), p['w1b'], p['w3b'], p['w2b'])
    return h, pool_state, vn


def setup_inputs(seed: int = 0) -> dict:
    ks = iter(jax.random.split(jax.random.key(seed), 64))
    nrm = lambda shape, scale: jax.random.normal(next(ks), shape, jnp.float32) * scale
    gain = lambda shape: 1.0 + 0.1 * jax.random.normal(next(ks), shape, jnp.float32)
    Lr = DEPTH
    return {
        "x_prompt": nrm((BATCH, SEQ, D_MODEL), 1.0),
        "x_sample": nrm((DEC_BATCH, DEC_SEQ, D_MODEL), 1.0),
        "state_pool": nrm((Lr, DEC_BATCH, POOL_STATE, D_POOL), 1.0),
        "cache_mem_k": nrm((Lr, DEC_BATCH, N_MEM, MEM_HEADS, MEM_HEAD_DIM), 1.0),
        "cache_mem_v": nrm((Lr, DEC_BATCH, N_MEM, MEM_HEADS, MEM_HEAD_DIM), 1.0),
        "mem_prompt": nrm((BATCH, N_MEM, D_MODEL), 1.0),
        "g_ff1": gain((Lr, D_MODEL)),
        "w1a": nrm((Lr, D_MODEL, D_FF), D_MODEL ** -0.5),
        "w3a": nrm((Lr, D_MODEL, D_FF), D_MODEL ** -0.5),
        "w2a": nrm((Lr, D_FF, D_MODEL), D_FF ** -0.5),
        "g_mix": gain((Lr, D_MODEL)),
        "w_in": nrm((Lr, D_MODEL, D_IN), D_MODEL ** -0.5),
        "b_gate": nrm((Lr, 2 * D_MODEL), 0.1),
        "w_pool": nrm((Lr, POOL_GROUPS, POOL_GW, POOL_GW), POOL_GW ** -0.5),
        "pool_scale": gain((Lr, D_POOL)),
        "g_sgu": gain((Lr, D_SGU)),
        "w_s": nrm((Lr, SGU_HEADS, SGU_CHUNK, SGU_CHUNK), SGU_CHUNK ** -0.5),
        "b_s": gain((Lr, SGU_HEADS, SGU_CHUNK)),
        "w_pa": nrm((Lr, D_POOL, D_MODEL), D_POOL ** -0.5),
        "w_pb": nrm((Lr, D_SGU, D_MODEL), D_SGU ** -0.5),
        "w_o": nrm((Lr, D_MODEL, D_MODEL), D_MODEL ** -0.5),
        "g_mem": gain((Lr, D_MODEL)),
        "w_mk": nrm((Lr, D_MODEL, D_MODEL), D_MODEL ** -0.5),
        "w_mv": nrm((Lr, D_MODEL, D_MODEL), D_MODEL ** -0.5),
        "g_ca": gain((Lr, D_MODEL)),
        "w_q": nrm((Lr, D_MODEL, D_MODEL), D_MODEL ** -0.5),
        "w_co": nrm((Lr, D_MODEL, D_MODEL), D_MODEL ** -0.5),
        "g_ff2": gain((Lr, D_MODEL)),
        "w1b": nrm((Lr, D_MODEL, D_FF), D_MODEL ** -0.5),
        "w3b": nrm((Lr, D_MODEL, D_FF), D_MODEL ** -0.5),
        "w2b": nrm((Lr, D_FF, D_MODEL), D_FF ** -0.5),
        "g_final": gain((D_MODEL,)),
    }


def reference(x_prompt, x_sample, state_pool, cache_mem_k, cache_mem_v, mem_prompt,
              g_ff1, w1a, w3a, w2a, g_mix, w_in, b_gate, w_pool, pool_scale, g_sgu, w_s, b_s,
              w_pa, w_pb, w_o, g_mem, w_mk, w_mv, g_ca, w_q, w_co, g_ff2, w1b, w3b, w2b, g_final):
    hp, hs = x_prompt, x_sample
    zero_prefix = jnp.zeros((x_prompt.shape[0], POOL_STATE, D_POOL), x_prompt.dtype)
    pool_p_list, pool_s_list, sgu_v_list, mk_list, mv_list = [], [], [], [], []
    for l in range(DEPTH):
        p = dict(g_ff1=g_ff1[l], w1a=w1a[l], w3a=w3a[l], w2a=w2a[l], g_mix=g_mix[l], w_in=w_in[l],
                 b_gate=b_gate[l], w_pool=w_pool[l], pool_scale=pool_scale[l], g_sgu=g_sgu[l],
                 w_s=w_s[l], b_s=b_s[l], w_pa=w_pa[l], w_pb=w_pb[l], w_o=w_o[l], g_ca=g_ca[l],
                 w_q=w_q[l], w_co=w_co[l], g_ff2=g_ff2[l], w1b=w1b[l], w3b=w3b[l], w2b=w2b[l])
        mk_p, mv_p = _mem_kv(mem_prompt, g_mem[l], w_mk[l], w_mv[l])
        hp, pool_p, _ = _layer(hp, mk_p, mv_p, zero_prefix, 0, True, p)
        hs, pool_s, sgu_v = _layer(hs, cache_mem_k[l], cache_mem_v[l], state_pool[l], PAST_LEN, False, p)
        pool_p_list.append(pool_p)
        pool_s_list.append(pool_s)
        sgu_v_list.append(sgu_v)
        mk_list.append(mk_p)
        mv_list.append(mv_p)
    y_prompt = _rmsnorm(hp, g_final)
    y_sample = _rmsnorm(hs, g_final)
    pool_prompt = jnp.stack(pool_p_list)
    pool_sample = jnp.stack(pool_s_list)
    sgu_v_sample = jnp.stack(sgu_v_list)
    mem_k_prompt = jnp.stack(mk_list)
    mem_v_prompt = jnp.stack(mv_list)
    return (y_prompt, y_sample, pool_prompt, pool_sample, sgu_v_sample, mem_k_prompt, mem_v_prompt)
```

```cpp
#include <hip/hip_runtime.h>
#include <cstdio>
#include <cstdint>
namespace pg8 {
#define PG8_LAS __attribute__((address_space(3)))
typedef unsigned short bf16_t;
typedef short bf16x8 __attribute__((ext_vector_type(8)));
typedef float f32x4 __attribute__((ext_vector_type(4)));
typedef unsigned u32x4 __attribute__((ext_vector_type(4)));
constexpr int BM = 256, BK = 64, HALF = 128, HTB = HALF * BK * 2  , STAGE_BYTES = 8 * HTB, NXCD = 8, WGM = 8;

__host__ __device__ __forceinline__ int lds_byte(int r, int c) { const int st = (r >> 4) * 2 + (c >> 5), rr = r & 15, cc = c & 31, ob = rr * 64 + cc * 2; return st * 1024 + (ob ^ (((ob >> 9) & 1) << 5)); }
__host__ __device__ __forceinline__ void stage_rc(int b, int& R, int& C) { const int st = b / 1024, sb = b % 1024, swz = sb ^ (((sb >> 9) & 1) << 5); R = (st >> 1) * 16 + swz / 64; C = (st & 1) * 32 + (swz % 64) / 2; }
__host__ __device__ __forceinline__ int perm32(int rho) { const int n = rho >> 4, i = rho & 15; return 8 * (i >> 2) + 4 * n + (i & 3); }

struct Unit { int pm, pn; };
struct Gemm { const bf16_t* A; const bf16_t* Bt; int M, N, K; };

struct StaticOrder {
    int nM, nN, nwg, G, c;
    __host__ __device__ void init(int M, int N, int G_, int c_) { nM = M / BM; nN = N / BM; nwg = nM * nN; G = G_; c = c_; }
    __host__ __device__ bool next(int i, Unit& u) const {
        const long L = (long)i * G + c; if (L >= nwg) return false;
        int wgid = (int)L; { const int q = nwg / NXCD, r = nwg % NXCD, xcd = wgid % NXCD, off = wgid / NXCD; wgid = (xcd < r ? xcd * (q + 1) : r * (q + 1) + (xcd - r) * q) + off; }
        const int nig = WGM * nN, gid = wgid / nig, fm = gid * WGM, gsz = (nM - fm) < WGM ? (nM - fm) : WGM;
        u.pm = fm + ((wgid % nig) % gsz); u.pn = (wgid % nig) / gsz; return true;
    }
    __device__ __forceinline__ void a_ready(const Unit&) const {}
    __device__ __forceinline__ void done(const Unit&) const {}
};

typedef __bf16 bf16x2_t __attribute__((ext_vector_type(2)));
typedef float f32x2_t __attribute__((ext_vector_type(2)));
__device__ __forceinline__ unsigned cvt_pk_bf16(float lo, float hi) { const f32x2_t v = {lo, hi}; const bf16x2_t b = __builtin_convertvector(v, bf16x2_t); return __builtin_bit_cast(unsigned, b); }
typedef float f32x2 __attribute__((ext_vector_type(2)));
constexpr float RMS_EPS = 1e-6f;
__device__ __forceinline__ float fast_sigmoid(float x) { return __builtin_amdgcn_rcpf(1.0f + __builtin_amdgcn_exp2f(-1.44269504089f * x)); }
__device__ __forceinline__ float silu_f(float a) { return a * fast_sigmoid(a); }
__device__ __forceinline__ float gelu_tanh_f(float x) { return x * fast_sigmoid(1.5957691216f * (x + 0.044715f * x * x * x)); }
__device__ __forceinline__ float bf_lo(unsigned w) { return __builtin_bit_cast(float, w << 16); }
__device__ __forceinline__ float bf_hi(unsigned w) { return __builtin_bit_cast(float, w & 0xffff0000u); }
__device__ __forceinline__ float row_rinv(const float* st, int row) {
    const f32x4* p = (const f32x4*)(st + (size_t)row * 16);
    const f32x4 a = p[0], b = p[1], c = p[2], d = p[3];
    const float s = (((a.x + a.y) + (a.z + a.w)) + ((b.x + b.y) + (b.z + b.w))) + (((c.x + c.y) + (c.z + c.w)) + ((d.x + d.y) + (d.z + d.w)));
    return __builtin_amdgcn_rsqf(s * (1.0f / 1024.0f) + RMS_EPS);
}
__device__ __forceinline__ u32x4 pack8(const float (&o)[8]) { u32x4 w; w.x = cvt_pk_bf16(o[0], o[1]); w.y = cvt_pk_bf16(o[2], o[3]); w.z = cvt_pk_bf16(o[4], o[5]); w.w = cvt_pk_bf16(o[6], o[7]); return w; }

struct EpiSwiglu {
    static constexpr bool PERM = true, AFTER_DRAIN = false;
    bf16_t* O; const float* st;
    __device__ __forceinline__ void operator()(const f32x4 (&acc)[2][2][4][2], const Unit& u, int wr, int wc, int fr_, int fq_) const {
        int fr = fr_, fq = fq_; asm volatile("" : "+v"(fr), "+v"(fq));
        const int row0 = u.pm * BM + wr * 64 + fr, col0 = u.pn * 128 + wc * 32 + 8 * fq;
#pragma unroll
        for (int ai = 0; ai < 2; ++ai)
#pragma unroll
            for (int m = 0; m < 4; ++m) {
                const int row = row0 + ai * HALF + m * 16;
                const float r = row_rinv(st, row);
                float o[8];
#pragma unroll
                for (int n = 0; n < 2; ++n)
#pragma unroll
                    for (int j = 0; j < 4; ++j) { const float a = acc[ai][0][m][n][j] * r, b = acc[ai][1][m][n][j] * r; o[n * 4 + j] = silu_f(a) * b; }
                *(u32x4*)(O + (size_t)row * 2816 + col0) = pack8(o);
                asm volatile("" ::: "memory");
            }
    }
};
struct EpiRes {
    static constexpr bool PERM = true, AFTER_DRAIN = false;
    const float* base0; const float* base1;
    float* out; bf16_t* hb; float* st; float scale;
    __device__ __forceinline__ void operator()(const f32x4 (&acc)[2][2][4][2], const Unit& u, int wr, int wc, int fr_, int fq_) const {
        int fr = fr_, fq = fq_; asm volatile("" : "+v"(fr), "+v"(fq));
        const float* bp = (u.pm < 128) ? base0 + (size_t)u.pm * BM * 1024 : base1 + (size_t)(u.pm - 128) * BM * 1024;
        const int lr0 = wr * 64 + fr, col0 = u.pn * BM + wc * 32 + 8 * fq;
#pragma unroll
        for (int ai = 0; ai < 2; ++ai)
#pragma unroll
            for (int m = 0; m < 4; ++m) {
                const int lr = lr0 + ai * HALF + m * 16; const int row = u.pm * BM + lr;
                float ss = 0.f;
#pragma unroll
                for (int bj = 0; bj < 2; ++bj) {
                    const float* b = bp + (size_t)lr * 1024 + col0 + bj * HALF;
                    const f32x4 b0 = *(const f32x4*)b, b1 = *(const f32x4*)(b + 4);
                    const f32x4 v0 = b0 + acc[ai][bj][m][0] * scale, v1 = b1 + acc[ai][bj][m][1] * scale;
                    float* op = out + (size_t)row * 1024 + col0 + bj * HALF;
                    *(f32x4*)op = v0; *(f32x4*)(op + 4) = v1;
                    if (hb) { u32x4 w; w.x = cvt_pk_bf16(v0.x, v0.y); w.y = cvt_pk_bf16(v0.z, v0.w); w.z = cvt_pk_bf16(v1.x, v1.y); w.w = cvt_pk_bf16(v1.z, v1.w); *(u32x4*)(hb + (size_t)row * 1024 + col0 + bj * HALF) = w; }
                    ss += ((v0.x * v0.x + v0.y * v0.y) + (v0.z * v0.z + v0.w * v0.w)) + ((v1.x * v1.x + v1.y * v1.y) + (v1.z * v1.z + v1.w * v1.w));
                }
                if (st) { ss += __shfl_xor(ss, 16); ss += __shfl_xor(ss, 32); if (fq == 0) st[(size_t)row * 16 + u.pn * 4 + wc] = ss; }
                asm volatile("" ::: "memory");
            }
    }
};
struct EpiZ {
    static constexpr bool PERM = true, AFTER_DRAIN = false;
    const float* st; bf16_t* xa; bf16_t* uu; bf16_t* vv; bf16_t* gate; float* stv; const float* b_gate; float* poolp; float* pools;
    __device__ __forceinline__ void operator()(const f32x4 (&acc)[2][2][4][2], const Unit& u, int wr, int wc, int fr_, int fq_) const {
        int fr = fr_, fq = fq_; asm volatile("" : "+v"(fr), "+v"(fq));
        const int row0 = u.pm * BM + wr * 64 + fr;
        const int kind = u.pn < 2 ? 0 : (u.pn < 4 ? 1 : (u.pn < 6 ? 2 : 3));
        const int tbase = u.pn < 2 ? 0 : (u.pn < 4 ? 2 : (u.pn < 6 ? 4 : 6));
        const int lc0 = (u.pn - tbase) * BM + wc * 32 + 8 * fq;
        if (kind == 0) {
#pragma unroll
            for (int ai = 0; ai < 2; ++ai)
#pragma unroll
                for (int m = 0; m < 4; ++m) {
                    const int row = row0 + ai * HALF + m * 16; const float r = row_rinv(st, row);
                    float* pdst = nullptr;
                    if (row < 32768) { const int t = row & 4095; if (t >= 4081) pdst = poolp + (size_t)((row >> 12) * 15 + (t - 4081)) * 512; }
                    else { const int sr = row - 32768, t = sr & 15; if (t >= 1) pdst = pools + (size_t)((sr >> 4) * 15 + (t - 1)) * 512; }
#pragma unroll
                    for (int bj = 0; bj < 2; ++bj) {
                        const f32x4 v0 = acc[ai][bj][m][0] * r, v1 = acc[ai][bj][m][1] * r; const int c = lc0 + bj * HALF;
                        u32x4 w; w.x = cvt_pk_bf16(v0.x, v0.y); w.y = cvt_pk_bf16(v0.z, v0.w); w.z = cvt_pk_bf16(v1.x, v1.y); w.w = cvt_pk_bf16(v1.z, v1.w);
                        *(u32x4*)(xa + (size_t)row * 512 + c) = w;
                        if (pdst) { *(f32x4*)(pdst + c) = v0; *(f32x4*)(pdst + c + 4) = v1; }
                    }
                }
        } else if (kind == 1) {
#pragma unroll
            for (int ai = 0; ai < 2; ++ai)
#pragma unroll
                for (int m = 0; m < 4; ++m) {
                    const int row = row0 + ai * HALF + m * 16; const float r = row_rinv(st, row);
#pragma unroll
                    for (int bj = 0; bj < 2; ++bj) {
                        float o[8];
#pragma unroll
                        for (int n = 0; n < 2; ++n)
#pragma unroll
                            for (int j = 0; j < 4; ++j) o[n * 4 + j] = gelu_tanh_f(acc[ai][bj][m][n][j] * r);
                        *(u32x4*)(uu + (size_t)row * 512 + lc0 + bj * HALF) = pack8(o);
                    }
                }
        } else if (kind == 2) {
#pragma unroll
            for (int ai = 0; ai < 2; ++ai)
#pragma unroll
                for (int m = 0; m < 4; ++m) {
                    const int row = row0 + ai * HALF + m * 16; const float r = row_rinv(st, row);
                    float s1 = 0.f, s2 = 0.f;
#pragma unroll
                    for (int bj = 0; bj < 2; ++bj) {
                        float o[8];
#pragma unroll
                        for (int n = 0; n < 2; ++n)
#pragma unroll
                            for (int j = 0; j < 4; ++j) { const float g = gelu_tanh_f(acc[ai][bj][m][n][j] * r); o[n * 4 + j] = g; s1 += g; s2 += g * g; }
                        *(u32x4*)(vv + (size_t)row * 512 + lc0 + bj * HALF) = pack8(o);
                    }
                    s1 += __shfl_xor(s1, 16); s1 += __shfl_xor(s1, 32); s2 += __shfl_xor(s2, 16); s2 += __shfl_xor(s2, 32);
                    if (fq == 0) { f32x2 sv; sv.x = s1; sv.y = s2; *(f32x2*)(stv + (size_t)row * 16 + ((u.pn - 4) * 4 + wc) * 2) = sv; }
                }
        } else {
            f32x4 bv[2][2];
#pragma unroll
            for (int bj = 0; bj < 2; ++bj)
#pragma unroll
                for (int n = 0; n < 2; ++n) bv[bj][n] = *(const f32x4*)(b_gate + lc0 + bj * HALF + 4 * n);
#pragma unroll
            for (int ai = 0; ai < 2; ++ai)
#pragma unroll
                for (int m = 0; m < 4; ++m) {
                    const int row = row0 + ai * HALF + m * 16; const float r = row_rinv(st, row);
#pragma unroll
                    for (int bj = 0; bj < 2; ++bj) {
                        float o[8];
#pragma unroll
                        for (int n = 0; n < 2; ++n)
#pragma unroll
                            for (int j = 0; j < 4; ++j) o[n * 4 + j] = fast_sigmoid(acc[ai][bj][m][n][j] * r + bv[bj][n][j]);
                        *(u32x4*)(gate + (size_t)row * 2048 + lc0 + bj * HALF) = pack8(o);
                    }
                }
        }
    }
};
template <bool ADD> struct EpiGate {
    static constexpr bool PERM = true, AFTER_DRAIN = false;
    const bf16_t* gate; bf16_t* mrg;
    __device__ __forceinline__ void operator()(const f32x4 (&acc)[2][2][4][2], const Unit& u, int wr, int wc, int fr_, int fq_) const {
        int fr = fr_, fq = fq_; asm volatile("" : "+v"(fr), "+v"(fq));
        const int row0 = u.pm * BM + wr * 64 + fr, col0 = u.pn * BM + wc * 32 + 8 * fq;
#pragma unroll
        for (int ai = 0; ai < 2; ++ai)
#pragma unroll
            for (int m = 0; m < 4; ++m) {
                const int row = row0 + ai * HALF + m * 16;
#pragma unroll
                for (int bj = 0; bj < 2; ++bj) {
                    const int c = col0 + bj * HALF;
                    const u32x4 g = *(const u32x4*)(gate + (size_t)row * 2048 + (ADD ? 1024 : 0) + c);
                    float o[8];
                    o[0] = acc[ai][bj][m][0].x * bf_lo(g.x); o[1] = acc[ai][bj][m][0].y * bf_hi(g.x); o[2] = acc[ai][bj][m][0].z * bf_lo(g.y); o[3] = acc[ai][bj][m][0].w * bf_hi(g.y);
                    o[4] = acc[ai][bj][m][1].x * bf_lo(g.z); o[5] = acc[ai][bj][m][1].y * bf_hi(g.z); o[6] = acc[ai][bj][m][1].z * bf_lo(g.w); o[7] = acc[ai][bj][m][1].w * bf_hi(g.w);
                    bf16_t* mp = mrg + (size_t)row * 1024 + c;
                    if (ADD) { const u32x4 t = *(const u32x4*)mp;
                        o[0] += bf_lo(t.x); o[1] += bf_hi(t.x); o[2] += bf_lo(t.y); o[3] += bf_hi(t.y); o[4] += bf_lo(t.z); o[5] += bf_hi(t.z); o[6] += bf_lo(t.w); o[7] += bf_hi(t.w); }
                    *(u32x4*)mp = pack8(o);
                }
                asm volatile("" ::: "memory");
            }
    }
};
struct EpiQ {
    static constexpr bool PERM = true, AFTER_DRAIN = false;
    const float* st; bf16_t* q; float qscale;
    __device__ __forceinline__ void operator()(const f32x4 (&acc)[2][2][4][2], const Unit& u, int wr, int wc, int fr_, int fq_) const {
        int fr = fr_, fq = fq_; asm volatile("" : "+v"(fr), "+v"(fq));
        const int row0 = u.pm * BM + wr * 64 + fr, col0 = u.pn * BM + wc * 32 + 8 * fq;
#pragma unroll
        for (int ai = 0; ai < 2; ++ai)
#pragma unroll
            for (int m = 0; m < 4; ++m) {
                const int row = row0 + ai * HALF + m * 16; const float r = row_rinv(st, row) * qscale;
#pragma unroll
                for (int bj = 0; bj < 2; ++bj) {
                    const f32x4 v0 = acc[ai][bj][m][0] * r, v1 = acc[ai][bj][m][1] * r;
                    u32x4 w; w.x = cvt_pk_bf16(v0.x, v0.y); w.y = cvt_pk_bf16(v0.z, v0.w); w.z = cvt_pk_bf16(v1.x, v1.y); w.w = cvt_pk_bf16(v1.z, v1.w);
                    *(u32x4*)(q + (size_t)row * 1024 + col0 + bj * HALF) = w;
                }
            }
    }
};
struct EpiKV {
    static constexpr bool PERM = true, AFTER_DRAIN = false;
    float* out_k; float* out_v; bf16_t* kb;
    __device__ __forceinline__ void operator()(const f32x4 (&acc)[2][2][4][2], const Unit& u, int wr, int wc, int fr_, int fq_) const {
        int fr = fr_, fq = fq_; asm volatile("" : "+v"(fr), "+v"(fq));
        const int row0 = u.pm * BM + wr * 64 + fr; const bool isk = u.pn < 4;
        const int col0 = (isk ? u.pn : u.pn - 4) * BM + wc * 32 + 8 * fq; float* of = isk ? out_k : out_v;
#pragma unroll
        for (int ai = 0; ai < 2; ++ai)
#pragma unroll
            for (int m = 0; m < 4; ++m) {
                const int row = row0 + ai * HALF + m * 16;
#pragma unroll
                for (int bj = 0; bj < 2; ++bj) {
                    const f32x4 v0 = acc[ai][bj][m][0], v1 = acc[ai][bj][m][1]; const int c = col0 + bj * HALF;
                    float* op = of + (size_t)row * 1024 + c; *(f32x4*)op = v0; *(f32x4*)(op + 4) = v1;
                    if (isk) { u32x4 w; w.x = cvt_pk_bf16(v0.x, v0.y); w.y = cvt_pk_bf16(v0.z, v0.w); w.z = cvt_pk_bf16(v1.x, v1.y); w.w = cvt_pk_bf16(v1.z, v1.w); *(u32x4*)(kb + (size_t)row * 1024 + c) = w; }
                }
            }
    }
};

template <class Epi, class Sched, bool ALIGN_EPI = false, bool SP2 = false>
__device__ __forceinline__ void gemm_phase(PG8_LAS unsigned char* lds, const Gemm g, const Sched& S, const Epi& E) {
    const int tid = threadIdx.x, wid = __builtin_amdgcn_readfirstlane(tid >> 6), lane = tid & 63, wr = wid >> 2, wc = wid & 3, fr = lane & 15, fq = lane >> 4;
    const int K = g.K, nt = K / BK;
    unsigned voffA[2], voffB[2];
#pragma unroll
    for (int i = 0; i < 2; ++i) { int R, C; stage_rc(tid * 16 + i * 8192, R, C); const int Rb = Epi::PERM ? ((R & ~31) + perm32(R & 31)) : R;
        voffA[i] = (unsigned)(R * K + C) * 2u; voffB[i] = (unsigned)(Rb * K + C) * 2u; }
    const size_t kstep = (size_t)(BK * 2);
    const size_t hstep = (size_t)HALF * K * 2;
    const size_t tstep = 2 * hstep;
    const unsigned ldsw = (unsigned)wid * 1024u;
    const int aoff = lds_byte(wr * 64 + fr, fq * 8), boff = lds_byte(wc * 32 + fr, fq * 8);
#define PG8_SA(b, h) (((b) * 2 + (h)) * HTB)
#define PG8_SB(b, h) ((4 + (b) * 2 + (h)) * HTB)
#define PG8_STAGE(bufoff, gbase, voff) do { _Pragma("unroll") for (int _i = 0; _i < 2; ++_i) \
        __builtin_amdgcn_global_load_lds((const unsigned*)((const char*)(gbase) + (voff)[_i]), (PG8_LAS unsigned*)(lds + (bufoff) + ldsw + _i * 8192), 16, 0, 0); } while (0)
#define PG8_LDA(dst, b, h) do { _Pragma("unroll") for (int m = 0; m < 4; ++m) _Pragma("unroll") for (int k = 0; k < 2; ++k) dst[m][k] = *(const PG8_LAS bf16x8*)(lds + PG8_SA(b, h) + aoff + m * 2048 + k * 1024); } while (0)
#define PG8_LDB(dst, b, h) do { _Pragma("unroll") for (int n = 0; n < 2; ++n) _Pragma("unroll") for (int k = 0; k < 2; ++k) dst[n][k] = *(const PG8_LAS bf16x8*)(lds + PG8_SB(b, h) + boff + n * 2048 + k * 1024); } while (0)
#define PG8_MMA(ai, bj, At, Bt) do { __builtin_amdgcn_s_setprio(1); _Pragma("unroll") for (int m = 0; m < 4; ++m) _Pragma("unroll") for (int n = 0; n < 2; ++n) _Pragma("unroll") for (int k = 0; k < 2; ++k) \
        acc[ai][bj][m][n] = __builtin_amdgcn_mfma_f32_16x16x32_bf16(Bt[n][k], At[m][k], acc[ai][bj][m][n], 0, 0, 0); __builtin_amdgcn_s_setprio(0); } while (0)
#define PG8_WAIT_V(n) asm volatile("s_waitcnt vmcnt(" #n ")" ::: "memory")
#define PG8_WAIT_L(n) asm volatile("s_waitcnt lgkmcnt(" #n ")" ::: "memory")
#define PG8_BAR __builtin_amdgcn_s_barrier()
#define PG8_SCHED __builtin_amdgcn_sched_barrier(0)
    Unit cur, nxt; int ui = 0;
    if (!S.next(0, cur)) return;
    f32x4 acc[2][2][4][2];
#pragma unroll
    for (int a = 0; a < 2; ++a)
#pragma unroll
        for (int b = 0; b < 2; ++b)
#pragma unroll
            for (int m = 0; m < 4; ++m)
#pragma unroll
                for (int n = 0; n < 2; ++n) acc[a][b][m][n] = (f32x4){0.f, 0.f, 0.f, 0.f};
    bf16x8 At[4][2], B0[2][2], B1[2][2];
    const char* cA = (const char*)g.A + (size_t)cur.pm * tstep; const char* cB = (const char*)g.Bt + (size_t)cur.pn * tstep;
    S.a_ready(cur);
    if constexpr (SP2) {
        PG8_STAGE(PG8_SB(0, 0), cB, voffB); PG8_STAGE(PG8_SB(0, 1), cB + hstep, voffB); PG8_STAGE(PG8_SA(0, 0), cA, voffA); PG8_STAGE(PG8_SA(0, 1), cA + hstep, voffA);
        if (wr == 1) PG8_BAR;
        PG8_WAIT_V(2); PG8_BAR;
        PG8_STAGE(PG8_SB(1, 0), cB + kstep, voffB); PG8_STAGE(PG8_SA(1, 0), cA + kstep, voffA); PG8_STAGE(PG8_SB(1, 1), cB + hstep + kstep, voffB);
        PG8_WAIT_V(6); PG8_BAR;
    } else {
        PG8_STAGE(PG8_SB(0, 0), cB, voffB); PG8_STAGE(PG8_SA(0, 0), cA, voffA); PG8_STAGE(PG8_SB(0, 1), cB + hstep, voffB); PG8_STAGE(PG8_SA(0, 1), cA + hstep, voffA);
        if (wr == 1) PG8_BAR;
        PG8_WAIT_V(4); PG8_BAR;
        PG8_STAGE(PG8_SB(1, 0), cB + kstep, voffB); PG8_STAGE(PG8_SA(1, 0), cA + kstep, voffA); PG8_STAGE(PG8_SB(1, 1), cB + hstep + kstep, voffB);
        PG8_WAIT_V(6); PG8_BAR;
    }
    for (;;) {
        const bool has_next = S.next(ui + 1, nxt);
        const char* nA = has_next ? (const char*)g.A + (size_t)nxt.pm * tstep : cA; const char* nB = has_next ? (const char*)g.Bt + (size_t)nxt.pn * tstep : cB;
        for (int t = 0; t < nt; t += 2) {
            const bool last = (t == nt - 2);
            const char* a1 = cA + (size_t)(t + 1) * kstep;
            const char* a2 = last ? nA : cA + (size_t)(t + 2) * kstep; const char* b2 = last ? nB : cB + (size_t)(t + 2) * kstep;
            const char* a3 = a2 + kstep; const char* b3 = b2 + kstep;
            if (last && has_next) S.a_ready(nxt);
            if constexpr (SP2) {
            PG8_LDB(B0, 0, 0); PG8_LDB(B1, 0, 1); PG8_SCHED; PG8_LDA(At, 0, 0); PG8_STAGE(PG8_SA(1, 1), a1 + hstep, voffA);
            PG8_WAIT_V(8); PG8_WAIT_L(0); PG8_BAR; PG8_MMA(0, 0, At, B0); PG8_MMA(0, 1, At, B1); PG8_BAR; PG8_SCHED;
            PG8_LDA(At, 0, 1); PG8_STAGE(PG8_SB(0, 0), b2, voffB); PG8_STAGE(PG8_SB(0, 1), b2 + hstep, voffB); PG8_STAGE(PG8_SA(0, 0), a2, voffA);
            PG8_WAIT_V(8); PG8_WAIT_L(0); PG8_BAR; PG8_MMA(1, 0, At, B0); PG8_MMA(1, 1, At, B1); PG8_BAR; PG8_SCHED;
            PG8_LDB(B0, 1, 0); PG8_LDB(B1, 1, 1); PG8_SCHED; PG8_LDA(At, 1, 0); PG8_STAGE(PG8_SA(0, 1), a2 + hstep, voffA);
            PG8_WAIT_V(8); PG8_WAIT_L(0); PG8_BAR; PG8_MMA(0, 0, At, B0); PG8_MMA(0, 1, At, B1); PG8_BAR; PG8_SCHED;
            PG8_LDA(At, 1, 1); PG8_STAGE(PG8_SB(1, 0), b3, voffB); PG8_STAGE(PG8_SB(1, 1), b3 + hstep, voffB); PG8_STAGE(PG8_SA(1, 0), a3, voffA);
            PG8_WAIT_V(8); PG8_WAIT_L(0); PG8_BAR; PG8_MMA(1, 0, At, B0); PG8_MMA(1, 1, At, B1); PG8_BAR; PG8_SCHED;
            } else {
            PG8_LDB(B0, 0, 0); PG8_SCHED; PG8_LDA(At, 0, 0); PG8_STAGE(PG8_SA(1, 1), a1 + hstep, voffA);
            PG8_WAIT_L(8); PG8_BAR; PG8_WAIT_L(0); PG8_MMA(0, 0, At, B0); PG8_BAR; PG8_SCHED;
            PG8_LDB(B1, 0, 1); PG8_STAGE(PG8_SB(0, 0), b2, voffB);
            PG8_BAR; PG8_WAIT_L(0); PG8_MMA(0, 1, At, B1); PG8_BAR;
            PG8_LDA(At, 0, 1); PG8_STAGE(PG8_SA(0, 0), a2, voffA);
            PG8_BAR; PG8_WAIT_L(0); PG8_MMA(1, 0, At, B0); PG8_BAR; PG8_SCHED;
            PG8_STAGE(PG8_SB(0, 1), b2 + hstep, voffB);
            PG8_WAIT_V(6); PG8_BAR; PG8_MMA(1, 1, At, B1); PG8_BAR;
            PG8_LDB(B0, 1, 0); PG8_SCHED; PG8_LDA(At, 1, 0); PG8_STAGE(PG8_SA(0, 1), a2 + hstep, voffA);
            PG8_WAIT_L(8); PG8_BAR; PG8_WAIT_L(0); PG8_MMA(0, 0, At, B0); PG8_BAR; PG8_SCHED;
            PG8_LDB(B1, 1, 1); PG8_STAGE(PG8_SB(1, 0), b3, voffB);
            PG8_BAR; PG8_WAIT_L(0); PG8_MMA(0, 1, At, B1); PG8_BAR;
            PG8_LDA(At, 1, 1); PG8_STAGE(PG8_SA(1, 0), a3, voffA);
            PG8_BAR; PG8_WAIT_L(0); PG8_MMA(1, 0, At, B0); PG8_BAR; PG8_SCHED;
            PG8_STAGE(PG8_SB(1, 1), b3 + hstep, voffB);
            PG8_WAIT_V(6); PG8_BAR; PG8_MMA(1, 1, At, B1); PG8_BAR;
            }
        }
        if constexpr (ALIGN_EPI) { if (wr == 0) PG8_BAR; }
        if constexpr (!Epi::AFTER_DRAIN) { E(acc, cur, wr, wc, fr, fq); S.done(cur); }
        if (!has_next) break;
#pragma unroll
        for (int a = 0; a < 2; ++a)
#pragma unroll
            for (int b = 0; b < 2; ++b)
#pragma unroll
                for (int m = 0; m < 4; ++m)
#pragma unroll
                    for (int n = 0; n < 2; ++n) acc[a][b][m][n] = (f32x4){0.f, 0.f, 0.f, 0.f};
        cur = nxt; cA = nA; cB = nB; ++ui;
        if constexpr (ALIGN_EPI) { if (wr == 1) PG8_BAR; }
    }
    PG8_WAIT_V(0);
    if constexpr (!ALIGN_EPI) { if (wr == 0) PG8_BAR; }
    PG8_BAR;
    if constexpr (Epi::AFTER_DRAIN) { E.fused(acc, cur, wr, wc, fr, fq, lds, wid, lane); S.done(cur); }
#undef PG8_SA
#undef PG8_SB
#undef PG8_STAGE
#undef PG8_LDA
#undef PG8_LDB
#undef PG8_MMA
#undef PG8_WAIT_V
#undef PG8_WAIT_L
#undef PG8_BAR
#undef PG8_SCHED
}
}
#define GAS __attribute__((address_space(1)))
#define LAS __attribute__((address_space(3)))
typedef unsigned short bf16;
typedef unsigned v4u __attribute__((ext_vector_type(4)));
typedef float f32x4 __attribute__((ext_vector_type(4)));
typedef short bf16x8 __attribute__((ext_vector_type(8)));
typedef GAS unsigned gu32;
typedef GAS unsigned long long gu64;
#define RLX_AGENT __ATOMIC_RELAXED, __HIP_MEMORY_SCOPE_AGENT
#define LDS_WAIT() asm volatile("s_waitcnt lgkmcnt(0)" ::: "memory")
#define VM_WAIT() asm volatile("s_waitcnt vmcnt(0)" ::: "memory")
__device__ __forceinline__ unsigned long long rt() { return __builtin_amdgcn_s_memrealtime(); }
__device__ __forceinline__ unsigned f2bf(float f) { unsigned u = __builtin_bit_cast(unsigned, f); return (u + 0x7fffu + ((u >> 16) & 1u)) >> 16; }
__device__ __forceinline__ unsigned pk2(float lo, float hi) { return f2bf(lo) | (f2bf(hi) << 16); }

#define XB_TMO      128
#define XB_XCNT(j)  (256  + 64 * (j))
#define XB_XSUB(j)  (1280 + 64 * (j))
#define XB_XGEN(j)  (2304 + 64 * (j))
#define XB_TOP      3328
#define XB_TOPGEN   3392
#define XCD_BAR_WORDS 3456
#define XB_SPIN_CAP (1u << 18)

__device__ __forceinline__ unsigned xb_ld(unsigned* p)              { return __hip_atomic_load(p, __ATOMIC_RELAXED, __HIP_MEMORY_SCOPE_AGENT); }
__device__ __forceinline__ unsigned xb_add(unsigned* p, unsigned v) { return __hip_atomic_fetch_add(p, v, __ATOMIC_RELAXED, __HIP_MEMORY_SCOPE_AGENT); }
__device__ __forceinline__ unsigned xb_xcc_id() { return (unsigned)__builtin_amdgcn_s_getreg((3 << 11) | 20) & 0xFu; }
#define XB_SPIN(cond, bar) do { unsigned _sp = 0; while (cond) { __builtin_amdgcn_s_sleep(1); \
    if ((++_sp & 255u) == 0u) { if (xb_ld(&(bar)[XB_TMO])) break; if (_sp > XB_SPIN_CAP) { atomicAdd(&(bar)[XB_TMO], 1u); break; } } } } while (0)

struct XcdBarrier {
    unsigned* bar; unsigned x;
    volatile LAS unsigned* st;
};

__device__ __forceinline__ XcdBarrier xcd_barrier_post(unsigned* bar, volatile LAS unsigned* st) {
    XcdBarrier b; b.bar = bar; b.x = xb_xcc_id(); b.st = st;
    if (threadIdx.x == 0) (void)xb_add(&bar[XB_XCNT(b.x)], 1u);
    return b;
}
__device__ __forceinline__ void xcd_barrier_complete(unsigned* bar, unsigned x, unsigned& nloc, unsigned& nx) {
    const unsigned G = gridDim.x * gridDim.y * gridDim.z;
    unsigned sum, cnt, mine, sp = 0u;
    for (;;) {
        sum = 0u; cnt = 0u; mine = 0u;
#pragma unroll
        for (unsigned j = 0; j < 16; ++j) { const unsigned c = xb_ld(&bar[XB_XCNT(j)]); sum += c; cnt += (c > 0u) ? 1u : 0u; mine = (j == x) ? c : mine; }
        if (sum == G) break;
        __builtin_amdgcn_s_sleep(1);
        if ((++sp & 255u) == 0u) { if (xb_ld(&bar[XB_TMO])) break; if (sp > XB_SPIN_CAP) { atomicAdd(&bar[XB_TMO], 1u); break; } }
    }
    nloc = mine > 0u ? mine : 1u; nx = cnt > 0u ? cnt : 1u;
}

__device__ __forceinline__ void xcd_barrier(const XcdBarrier& b) {
    asm volatile("s_waitcnt vmcnt(0)" ::: "memory");
    __syncthreads();
    if (threadIdx.x == 0) {
        unsigned* bar = b.bar;
        __builtin_amdgcn_s_waitcnt(0);
        unsigned nloc = b.st[0], nx = b.st[1];
        if (nloc == 0u) { xcd_barrier_complete(bar, b.x, nloc, nx); b.st[0] = nloc; b.st[1] = nx; }
        const unsigned old = xb_add(&bar[XB_XSUB(b.x)], 1u);
        const unsigned gen = old / nloc;
        if (old + 1u == (gen + 1u) * nloc) {
            __builtin_amdgcn_fence(__ATOMIC_RELEASE, "agent");
            asm volatile("s_waitcnt vmcnt(0)" ::: "memory");
            const unsigned og = xb_add(&bar[XB_TOP], 1u);
            const unsigned tg = og / nx;
            if (og + 1u == (tg + 1u) * nx) xb_add(&bar[XB_TOPGEN], 1u);
            else XB_SPIN(xb_ld(&bar[XB_TOPGEN]) == tg, bar);
            __builtin_amdgcn_fence(__ATOMIC_ACQUIRE, "agent");
            xb_add(&bar[XB_XGEN(b.x)], 1u);
            asm volatile("s_waitcnt vmcnt(0)" ::: "memory");
        } else {
            XB_SPIN(xb_ld(&bar[XB_XGEN(b.x)]) == gen, bar);
            __builtin_amdgcn_fence(__ATOMIC_ACQUIRE, "agent");
            asm volatile("s_waitcnt vmcnt(0)" ::: "memory");
        }
    }
    __syncthreads();
}
using pg8::bf_lo; using pg8::bf_hi;
constexpr int DM = 1024, MP = 8 * 4096, MS = 32 * 16, MT = MP + MS;
constexpr int DFF = 2816, DIN = 3584, MMEM = 8 * 256, NKV = 40;
constexpr size_t OFF_Y = 0, OFF_POOLP = (size_t)MT * DM, OFF_POOLS = OFF_POOLP + 8 * 15 * 512, OFF_SGUV = OFF_POOLS + 32 * 15 * 512,
                 OFF_MK = OFF_SGUV + 32 * 16 * 512, OFF_MV = OFF_MK + (size_t)MMEM * DM, OUT_TOTAL = OFF_MV + (size_t)MMEM * DM;
constexpr int NWAVES = 8;
#ifndef MK_PER_PHASE
#define MK_PER_PHASE 1
#endif
constexpr int N_PHASES = 14;

constexpr size_t al256(size_t x) { return (x + 255) & ~(size_t)255; }
constexpr size_t WS_CTL = 0, CTL_ZERO_BYTES = 1u << 20;
constexpr size_t WS_W13A = CTL_ZERO_BYTES;
constexpr size_t WS_W2A  = WS_W13A + al256((size_t)2 * DFF * DM * 2);
constexpr size_t WS_WIN  = WS_W2A  + al256((size_t)DM * DFF * 2);
constexpr size_t WS_WA   = WS_WIN  + al256((size_t)DIN * DM * 2);
constexpr size_t WS_WPB  = WS_WA   + al256((size_t)DM * 512 * 2);
constexpr size_t WS_WO   = WS_WPB  + al256((size_t)DM * 512 * 2);
constexpr size_t WS_WMKV = WS_WO   + al256((size_t)DM * DM * 2);
constexpr size_t WS_WQ   = WS_WMKV + al256((size_t)2 * DM * DM * 2);
constexpr size_t WS_WCO  = WS_WQ   + al256((size_t)DM * DM * 2);
constexpr size_t WS_W13B = WS_WCO  + al256((size_t)DM * DM * 2);
constexpr size_t WS_W2B  = WS_W13B + al256((size_t)2 * DFF * DM * 2);
constexpr size_t WS_WSP  = WS_W2B  + al256((size_t)DM * DFF * 2);
constexpr size_t WS_WSS  = WS_WSP  + al256((size_t)4 * 128 * 128 * 2);
constexpr size_t WS_HB   = WS_WSS  + al256((size_t)4 * 128 * 128 * 2);
constexpr size_t WS_MEMN = WS_HB   + al256((size_t)MT * DM * 2);
constexpr size_t WS_KB   = WS_MEMN + al256((size_t)MMEM * DM * 2);
constexpr size_t WS_VT   = WS_KB   + al256((size_t)NKV * 256 * DM * 2);
constexpr size_t WS_ST0  = WS_VT   + al256((size_t)NKV * 256 * DM * 2);
constexpr size_t WS_ST1  = WS_ST0  + al256((size_t)MT * 64);
constexpr size_t WS_ST2  = WS_ST1  + al256((size_t)MT * 64);
constexpr size_t WS_ST3  = WS_ST2  + al256((size_t)MT * 64);
constexpr size_t WS_STV  = WS_ST3  + al256((size_t)MT * 64);
constexpr size_t WS_RACT = WS_STV  + al256((size_t)MT * 64);
constexpr size_t WS_GATE = WS_RACT, WS_DD = WS_GATE + (size_t)MT * 2048 * 2;
constexpr size_t WS_RZ   = WS_RACT + al256((size_t)MT * DFF * 2);
constexpr size_t WS_XA = WS_RZ, WS_UU = WS_XA + (size_t)MT * 512 * 2, WS_VV = WS_UU + (size_t)MT * 512 * 2, WS_US = WS_VV + (size_t)MT * 512 * 2;
constexpr size_t WS_MRG = WS_RZ, WS_QB = WS_RZ, WS_OB = WS_RZ + (size_t)MT * DM * 2;
constexpr size_t WS_END = WS_RZ + al256((size_t)MT * 2048 * 2);
static_assert(WS_DD + (size_t)MT * 512 * 2 <= WS_RZ, "gate | dd fit in the act region");
static_assert(WS_END <= (size_t)512 * 1024 * 1024, "d_ws map fits 512 MiB");
constexpr int CW_BAR = 4096;

constexpr int RING_BYTES = 131072, LDSCTL_OFF = RING_BYTES, MISC_OFF = LDSCTL_OFF + 320, LDS_BYTES = 147456;

__device__ __forceinline__ float wave_sum(float v) {
#pragma unroll
    for (int o = 1; o < 64; o <<= 1) v += __shfl_xor(v, o);
    return v;
}
__device__ __forceinline__ void transpose_item(const float* W, int ldn, int k0, int n0, const float* gain, bf16* WT, int ldk, int drow0, LAS float* scr, int lane) {
#pragma unroll 8
    for (int i = 0; i < 32; ++i) { const int kk = 2 * i + (lane >> 5); float v = W[(size_t)(k0 + kk) * ldn + n0 + (lane & 31)]; if (gain) v *= gain[k0 + kk]; scr[kk * 33 + (lane & 31)] = v; }
    LDS_WAIT(); asm volatile("" ::: "memory");
    const int c = lane & 7;
#pragma unroll
    for (int j = 0; j < 4; ++j) { const int n = (lane >> 3) + 8 * j; const LAS float* s = scr + (8 * c) * 33 + n;
        v4u o; o.x = pk2(s[0 * 33], s[1 * 33]); o.y = pk2(s[2 * 33], s[3 * 33]); o.z = pk2(s[4 * 33], s[5 * 33]); o.w = pk2(s[6 * 33], s[7 * 33]);
        *(v4u*)(WT + (size_t)(drow0 + n) * ldk + k0 + 8 * c) = o; }
    LDS_WAIT(); asm volatile("" ::: "memory");
}

struct Args { const float* in[32]; float* out; unsigned char* ws; int ph_lo, ph_hi; };

__device__ __forceinline__ void phase_prologue(const Args& A, LAS unsigned char* lds, int tid, int wave, int lane, int vcu, int G) {
    unsigned char* ws = A.ws;
    LAS float* scr = (LAS float*)(lds + wave * 16384);
    const int gw = vcu * NWAVES + wave, NGW = G * NWAVES;
    constexpr int I_W1 = (DM / 64) * (DFF / 32), I_W2 = (DFF / 64) * (DM / 32), I_WIN = (DM / 64) * (DIN / 32), I_PB = (512 / 64) * (DM / 32), I_SQ = (DM / 64) * (DM / 32), I_VT = 32 * (256 / 64) * (DM / 32);
    constexpr int NITEMS = 4 * I_W1 + 2 * I_W2 + I_WIN + I_PB + 5 * I_SQ + I_VT;
    for (int it = gw; it < NITEMS; it += NGW) {
        int r = it;
#define W13_ITEM(SRC, GAIN, DST, HALFSEL) if (r < I_W1) { const int nblk = DFF / 32, kb = r / nblk, nb = r % nblk, n0 = 32 * nb; \
            transpose_item(SRC, DFF, 64 * kb, n0, GAIN, (bf16*)(ws + DST), DM, (n0 >> 7) * 256 + HALFSEL * 128 + (n0 & 127), scr, lane); continue; } r -= I_W1;
#define PLAIN_ITEM(SRC, KK, NN, GAIN, DST, ROWOFF, CNT) if (r < CNT) { const int nblk = NN / 32, kb = r / nblk, nb = r % nblk; \
            transpose_item(SRC, NN, 64 * kb, 32 * nb, GAIN, (bf16*)(ws + DST), KK, ROWOFF + 32 * nb, scr, lane); continue; } r -= CNT;
        W13_ITEM(A.in[7], A.in[6], WS_W13A, 0)
        W13_ITEM(A.in[8], A.in[6], WS_W13A, 1)
        W13_ITEM(A.in[28], A.in[27], WS_W13B, 0)
        W13_ITEM(A.in[29], A.in[27], WS_W13B, 1)
        PLAIN_ITEM(A.in[9], DFF, DM, nullptr, WS_W2A, 0, I_W2)
        PLAIN_ITEM(A.in[30], DFF, DM, nullptr, WS_W2B, 0, I_W2)
        PLAIN_ITEM(A.in[11], DM, DIN, A.in[10], WS_WIN, 0, I_WIN)
        PLAIN_ITEM(A.in[19], 512, DM, nullptr, WS_WPB, 0, I_PB)
        PLAIN_ITEM(A.in[20], DM, DM, nullptr, WS_WO, 0, I_SQ)
        PLAIN_ITEM(A.in[22], DM, DM, nullptr, WS_WMKV, 0, I_SQ)
        PLAIN_ITEM(A.in[23], DM, DM, nullptr, WS_WMKV, 1024, I_SQ)
        PLAIN_ITEM(A.in[25], DM, DM, A.in[24], WS_WQ, 0, I_SQ)
        PLAIN_ITEM(A.in[26], DM, DM, nullptr, WS_WCO, 0, I_SQ)
        {
            const int b = r / 128, rr = r % 128, kb = rr / 32, nb = rr % 32;
            transpose_item(A.in[4] + (size_t)b * 256 * DM, DM, 64 * kb, 32 * nb, nullptr, (bf16*)(ws + WS_VT) + (size_t)(8 + b) * DM * 256, 256, 32 * nb, scr, lane);
        }
#undef W13_ITEM
#undef PLAIN_ITEM
    }
    constexpr int NROWS = MT + MMEM + 32 * 256;
    for (int rr = gw; rr < NROWS; rr += NGW) {
        const float* src; bf16* dst; int kind;
        if (rr < MT) { kind = 0; src = (rr < MP) ? A.in[0] + (size_t)rr * DM : A.in[1] + (size_t)(rr - MP) * DM; dst = (bf16*)(ws + WS_HB) + (size_t)rr * DM; }
        else if (rr < MT + MMEM) { kind = 1; src = A.in[5] + (size_t)(rr - MT) * DM; dst = (bf16*)(ws + WS_MEMN) + (size_t)(rr - MT) * DM; }
        else { kind = 2; src = A.in[3] + (size_t)(rr - MT - MMEM) * DM; dst = (bf16*)(ws + WS_KB) + (size_t)(8 * 256 + (rr - MT - MMEM)) * DM; }
        const f32x4* xr = (const f32x4*)src + lane;
        f32x4 v[4]; float s = 0.f;
#pragma unroll
        for (int j = 0; j < 4; ++j) { v[j] = xr[64 * j]; s += (v[j].x * v[j].x + v[j].y * v[j].y) + (v[j].z * v[j].z + v[j].w * v[j].w); }
        if (kind != 2) s = wave_sum(s);
        if (kind == 0) { float* st = (float*)(ws + WS_ST0) + (size_t)rr * 16; if (lane < 16) st[lane] = (lane == 0) ? s : 0.f; }
        if (kind == 1) { const float rin = 1.0f / sqrtf(s * (1.0f / DM) + 1e-6f); const f32x4* gr = (const f32x4*)A.in[21] + lane;
#pragma unroll
            for (int j = 0; j < 4; ++j) v[j] = v[j] * rin * gr[64 * j]; }
        unsigned long long* o8 = (unsigned long long*)dst + lane;
#pragma unroll
        for (int j = 0; j < 4; ++j) o8[64 * j] = (unsigned long long)pk2(v[j].x, v[j].y) | ((unsigned long long)pk2(v[j].z, v[j].w) << 32);
    }
    const int gt = vcu * (NWAVES * 64) + tid, NGT = G * NWAVES * 64;
    for (int idx = gt; idx < 512 * 1024; idx += NGT) {
        const int k = idx >> 10, n = idx & 1023, g = k >> 7;
        const float* wp = A.in[13] + (size_t)k * 128; const float* ps = A.in[14] + g * 128; const float* pa = A.in[18] + (size_t)(g * 128) * DM + n;
        float acc = 0.f;
#pragma unroll 8
        for (int d = 0; d < 128; ++d) acc += wp[d] * ps[d] * pa[(size_t)d * DM];
        ((bf16*)(ws + WS_WA))[(size_t)n * 512 + k] = (bf16)f2bf(acc);
    }
    for (int idx = gt; idx < 2 * 65536; idx += NGT) {
        const int smp = idx >> 16, h = (idx >> 14) & 3, p = (idx >> 7) & 127, q = idx & 127;
        float w;
        if (!smp) w = ((p >> 6) >= (q >> 6)) ? A.in[16][(size_t)(h * 128 + p) * 128 + q] : 0.f;
        else w = ((p >> 4) == (q >> 4)) ? A.in[16][(size_t)(h * 128 + (p & 15)) * 128 + (q & 15)] : 0.f;
        ((bf16*)(ws + (smp ? WS_WSS : WS_WSP)))[(size_t)(h * 128 + p) * 128 + q] = (bf16)f2bf(w);
    }
}

__device__ __forceinline__ void phase_mixprep(const Args& A, LAS unsigned char* lds, int tid, int wave, int lane, int vcu, int G) {
    unsigned char* ws = A.ws;
    const int gw = vcu * NWAVES + wave, NGW = G * NWAVES;
    {
        LAS float* scr = (LAS float*)(lds + wave * 16384);
        for (int it = gw; it < 8 * 128; it += NGW) { const int b = it / 128, rr = it % 128, kb = rr / 32, nb = rr % 32;
            transpose_item(A.out + OFF_MV + (size_t)b * 256 * DM, DM, 64 * kb, 32 * nb, nullptr, (bf16*)(ws + WS_VT) + (size_t)b * DM * 256, 256, 32 * nb, scr, lane); }
    }
    {
        const bf16* xa = (const bf16*)(ws + WS_XA); bf16* dd = (bf16*)(ws + WS_DD);
        const int gt = vcu * (NWAVES * 64) + tid, NGT = G * NWAVES * 64;
        for (int idx = gt; idx < MT * 64; idx += NGT) {
            const int row = idx >> 6, cg = idx & 63, w = 2 << (cg >> 4);
            float s[8];
#pragma unroll
            for (int j = 0; j < 8; ++j) s[j] = 0.f;
            float self[8]; float cnt;
            const v4u x0 = *(const v4u*)(xa + (size_t)row * 512 + cg * 8);
            self[0] = bf_lo(x0.x); self[1] = bf_hi(x0.x); self[2] = bf_lo(x0.y); self[3] = bf_hi(x0.y); self[4] = bf_lo(x0.z); self[5] = bf_hi(x0.z); self[6] = bf_lo(x0.w); self[7] = bf_hi(x0.w);
            if (row < MP) {
                const int t = row & 4095; const int nv = (t + 1 < w) ? t + 1 : w; cnt = (float)nv;
                for (int j = 0; j < nv; ++j) { const v4u x = *(const v4u*)(xa + (size_t)(row - j) * 512 + cg * 8);
                    s[0] += bf_lo(x.x); s[1] += bf_hi(x.x); s[2] += bf_lo(x.y); s[3] += bf_hi(x.y); s[4] += bf_lo(x.z); s[5] += bf_hi(x.z); s[6] += bf_lo(x.w); s[7] += bf_hi(x.w); }
            } else {
                const int sr = row - MP, t = sr & 15, sb = sr >> 4; cnt = (float)w;
                for (int j = 0; j < w; ++j) {
                    if (t - j >= 0) { const v4u x = *(const v4u*)(xa + (size_t)(row - j) * 512 + cg * 8);
                        s[0] += bf_lo(x.x); s[1] += bf_hi(x.x); s[2] += bf_lo(x.y); s[3] += bf_hi(x.y); s[4] += bf_lo(x.z); s[5] += bf_hi(x.z); s[6] += bf_lo(x.w); s[7] += bf_hi(x.w); }
                    else { const float* sp = A.in[2] + ((size_t)sb * 15 + (15 + t - j)) * 512 + cg * 8; const f32x4 a = *(const f32x4*)sp, b = *(const f32x4*)(sp + 4);
                        s[0] += a.x; s[1] += a.y; s[2] += a.z; s[3] += a.w; s[4] += b.x; s[5] += b.y; s[6] += b.z; s[7] += b.w; }
                }
            }
            const float ic = 1.0f / cnt;
            v4u o; o.x = pk2(s[0] * ic - self[0], s[1] * ic - self[1]); o.y = pk2(s[2] * ic - self[2], s[3] * ic - self[3]); o.z = pk2(s[4] * ic - self[4], s[5] * ic - self[5]); o.w = pk2(s[6] * ic - self[6], s[7] * ic - self[7]);
            *(v4u*)(dd + (size_t)row * 512 + cg * 8) = o;
        }
    }
    __syncthreads();
    {
        const bf16* vv = (const bf16*)(ws + WS_VV); const bf16* uu = (const bf16*)(ws + WS_UU); bf16* us = (bf16*)(ws + WS_US);
        const float* stv = (const float*)(ws + WS_STV);
        LAS bf16* VT = (LAS bf16*)lds;
        LAS float* MU = (LAS float*)(lds + 40960); LAS float* RS = MU + 128;
        const int fr = lane & 15, fq = lane >> 4;
        for (int un = vcu; un < (MT / 128) * 4; un += G) {
            const int ci = un >> 2, hd = un & 3, row0 = ci * 128; const bool smp = row0 >= MP;
            if (tid < 128) {
                const f32x4* p = (const f32x4*)(stv + (size_t)(row0 + tid) * 16); const f32x4 a = p[0], b = p[1], c = p[2], d = p[3];
                const float sum = ((a.x + a.z) + (b.x + b.z)) + ((c.x + c.z) + (d.x + d.z)), sq = ((a.y + a.w) + (b.y + b.w)) + ((c.y + c.w) + (d.y + d.w));
                const float mean = sum * (1.0f / 512.0f); float var = sq * (1.0f / 512.0f) - mean * mean; var = var > 0.f ? var : 0.f;
                MU[tid] = mean; RS[tid] = 1.0f / sqrtf(var + 1e-6f);
            }
            __syncthreads();
#pragma unroll 1
            for (int it = 0; it < 4; ++it) {
                const int idx = it * 512 + tid, q = idx >> 4, c8 = idx & 15, row = row0 + q;
                const v4u raw = *(const v4u*)(vv + (size_t)row * 512 + hd * 128 + c8 * 8);
                const float mu = MU[q], rs = RS[q];
                const f32x4 g0 = *(const f32x4*)(A.in[15] + hd * 128 + c8 * 8), g1 = *(const f32x4*)(A.in[15] + hd * 128 + c8 * 8 + 4);
                float x[8];
                x[0] = (bf_lo(raw.x) - mu) * rs * g0.x; x[1] = (bf_hi(raw.x) - mu) * rs * g0.y; x[2] = (bf_lo(raw.y) - mu) * rs * g0.z; x[3] = (bf_hi(raw.y) - mu) * rs * g0.w;
                x[4] = (bf_lo(raw.z) - mu) * rs * g1.x; x[5] = (bf_hi(raw.z) - mu) * rs * g1.y; x[6] = (bf_lo(raw.w) - mu) * rs * g1.z; x[7] = (bf_hi(raw.w) - mu) * rs * g1.w;
                if (smp) { float* dst = A.out + OFF_SGUV + (size_t)(row - MP) * 512 + hd * 128 + c8 * 8; *(f32x4*)dst = (f32x4){x[0], x[1], x[2], x[3]}; *(f32x4*)(dst + 4) = (f32x4){x[4], x[5], x[6], x[7]}; }
#pragma unroll
                for (int j = 0; j < 8; ++j) VT[(c8 * 8 + j) * 136 + q] = (bf16)f2bf(x[j]);
            }
            __syncthreads();
            const bf16* wsel = (const bf16*)(ws + (smp ? WS_WSS : WS_WSP)) + (size_t)hd * 128 * 128;
            const int p = wave * 16 + fr;
            f32x4 acc[8];
#pragma unroll
            for (int nt = 0; nt < 8; ++nt) acc[nt] = (f32x4){0.f, 0.f, 0.f, 0.f};
#pragma unroll
            for (int ks = 0; ks < 4; ++ks) {
                const bf16x8 wf = *(const bf16x8*)(wsel + (size_t)p * 128 + ks * 32 + 8 * fq);
#pragma unroll
                for (int nt = 0; nt < 8; ++nt) { const bf16x8 vf = *(const LAS bf16x8*)(VT + (nt * 16 + fr) * 136 + ks * 32 + 8 * fq);
                    acc[nt] = __builtin_amdgcn_mfma_f32_16x16x32_bf16(vf, wf, acc[nt], 0, 0, 0); }
            }
            const float bias = A.in[17][hd * 128 + (smp ? fr : p)];
            const int row = row0 + p;
#pragma unroll
            for (int nt = 0; nt < 8; ++nt) { const int col = hd * 128 + nt * 16 + 4 * fq;
                const unsigned long long ur = *(const unsigned long long*)(uu + (size_t)row * 512 + col); const unsigned u0 = (unsigned)ur, u1 = (unsigned)(ur >> 32);
                const float o0 = bf_lo(u0) * (acc[nt].x + bias), o1 = bf_hi(u0) * (acc[nt].y + bias), o2 = bf_lo(u1) * (acc[nt].z + bias), o3 = bf_hi(u1) * (acc[nt].w + bias);
                *(unsigned long long*)(us + (size_t)row * 512 + col) = (unsigned long long)pk2(o0, o1) | ((unsigned long long)pk2(o2, o3) << 32); }
            __syncthreads();
        }
    }
}

__device__ __forceinline__ void phase_attention(const Args& A, LAS unsigned char* lds, int wave, int lane, int vcu, int G) {
    unsigned char* ws = A.ws;
    const bf16* qb = (const bf16*)(ws + WS_QB); const bf16* kb = (const bf16*)(ws + WS_KB); const bf16* vt = (const bf16*)(ws + WS_VT); bf16* ob = (bf16*)(ws + WS_OB);
    LAS bf16* P = (LAS bf16*)(lds + wave * 16384);
    LAS float* SUM = (LAS float*)(lds + wave * 16384 + 8448);
    const int fr = lane & 15, fq = lane >> 4;
    for (int W = vcu; W < (MT / 128) * 4; W += G) {
        const int blk = W >> 2, hd = W & 3, r0 = (blk * 8 + wave) * 16;
        const int kvb = (r0 < MP) ? (r0 >> 12) : 8 + ((r0 - MP) >> 4);
        bf16x8 qf[8];
        const bf16* qp = qb + (size_t)(r0 + fr) * DM + hd * 256 + 8 * fq;
#pragma unroll
        for (int ks = 0; ks < 8; ++ks) qf[ks] = *(const bf16x8*)(qp + ks * 32);
        f32x4 s[16];
        const bf16* kp = kb + ((size_t)kvb * 256 + fr) * DM + hd * 256 + 8 * fq;
#pragma unroll
        for (int nt = 0; nt < 16; ++nt) { s[nt] = (f32x4){0.f, 0.f, 0.f, 0.f};
#pragma unroll
            for (int ks = 0; ks < 8; ++ks) { const bf16x8 kf = *(const bf16x8*)(kp + (size_t)nt * 16 * DM + ks * 32); s[nt] = __builtin_amdgcn_mfma_f32_16x16x32_bf16(qf[ks], kf, s[nt], 0, 0, 0); } }
        float mx[4], sm[4];
#pragma unroll
        for (int j = 0; j < 4; ++j) { float m = s[0][j];
#pragma unroll
            for (int nt = 1; nt < 16; ++nt) m = fmaxf(m, s[nt][j]);
            m = fmaxf(m, __shfl_xor(m, 1)); m = fmaxf(m, __shfl_xor(m, 2)); m = fmaxf(m, __shfl_xor(m, 4)); m = fmaxf(m, __shfl_xor(m, 8)); mx[j] = m; sm[j] = 0.f; }
#pragma unroll
        for (int nt = 0; nt < 16; ++nt)
#pragma unroll
            for (int j = 0; j < 4; ++j) { const float p = __builtin_amdgcn_exp2f(s[nt][j] - mx[j]); sm[j] += p; P[(4 * fq + j) * 264 + nt * 16 + fr] = (bf16)f2bf(p); }
#pragma unroll
        for (int j = 0; j < 4; ++j) { float t = sm[j]; t += __shfl_xor(t, 1); t += __shfl_xor(t, 2); t += __shfl_xor(t, 4); t += __shfl_xor(t, 8); if (fr == 0) SUM[4 * fq + j] = t; }
        LDS_WAIT(); asm volatile("" ::: "memory"); __builtin_amdgcn_wave_barrier();
        bf16x8 pf[8];
#pragma unroll
        for (int ks = 0; ks < 8; ++ks) pf[ks] = *(const LAS bf16x8*)(P + fr * 264 + ks * 32 + 8 * fq);
        const float inv = 1.0f / SUM[fr];
        const bf16* vp = vt + ((size_t)kvb * DM + hd * 256 + fr) * 256 + 8 * fq;
        bf16* op = ob + (size_t)(r0 + fr) * DM + hd * 256 + 4 * fq;
#pragma unroll 4
        for (int dt = 0; dt < 16; ++dt) { f32x4 o = (f32x4){0.f, 0.f, 0.f, 0.f};
#pragma unroll
            for (int ks = 0; ks < 8; ++ks) { const bf16x8 vf = *(const bf16x8*)(vp + (size_t)dt * 16 * 256 + ks * 32); o = __builtin_amdgcn_mfma_f32_16x16x32_bf16(vf, pf[ks], o, 0, 0, 0); }
            *(unsigned long long*)(op + dt * 16) = (unsigned long long)pk2(o.x * inv, o.y * inv) | ((unsigned long long)pk2(o.z * inv, o.w * inv) << 32); }
        LDS_WAIT(); asm volatile("" ::: "memory"); __builtin_amdgcn_wave_barrier();
    }
}

__device__ __forceinline__ void phase_final(const Args& A, int wave, int lane, int vcu, int G) {
    const int gw = vcu * NWAVES + wave, NGW = G * NWAVES;
    const f32x4* gr = (const f32x4*)A.in[31] + lane;
    for (int row = gw; row < MT; row += NGW) {
        f32x4* xr = (f32x4*)(A.out + OFF_Y + (size_t)row * DM) + lane;
        f32x4 v[4]; float s = 0.f;
#pragma unroll
        for (int j = 0; j < 4; ++j) { v[j] = xr[64 * j]; s += (v[j].x * v[j].x + v[j].y * v[j].y) + (v[j].z * v[j].z + v[j].w * v[j].w); }
        const float rin = 1.0f / sqrtf(wave_sum(s) * (1.0f / DM) + 1e-6f);
#pragma unroll
        for (int j = 0; j < 4; ++j) xr[64 * j] = v[j] * rin * gr[64 * j];
    }
}

__global__ void __launch_bounds__(NWAVES * 64, 2) fwd_kernel(Args args) {
    extern __shared__ __attribute__((aligned(16))) unsigned char lds_raw[];
    LAS unsigned char* lds = (LAS unsigned char*)lds_raw;
    volatile LAS unsigned* MISC = (volatile LAS unsigned*)(lds + MISC_OFF);
    const int tid = threadIdx.x, lane = tid & 63, wave = __builtin_amdgcn_readfirstlane(tid >> 6);
    const int G = gridDim.x; const int bx = blockIdx.x; const int vcu = (G % 8 == 0) ? (bx % 8) * (G / 8) + bx / 8 : bx;
    unsigned char* ws = args.ws;
    gu32* ctl = (gu32*)(ws + WS_CTL);
    for (int u = tid; u < (LDS_BYTES - LDSCTL_OFF) / 4; u += NWAVES * 64) ((LAS unsigned*)(lds + LDSCTL_OFF))[u] = 0u;
    __syncthreads();
    XcdBarrier bar; bar.bar = (unsigned*)(ctl + CW_BAR); bar.x = 0; bar.st = nullptr;
    if (!MK_PER_PHASE) bar = xcd_barrier_post((unsigned*)(ctl + CW_BAR), MISC + 8);
    const int lo = args.ph_lo, hi = args.ph_hi;
#ifndef PH_MASK
#define PH_MASK 0x3fff
#endif
#define IN(k) (((PH_MASK >> (k)) & 1) && lo <= (k) && (k) < hi)
#define SEAM(k) do { if (IN(k) && IN((k) + 1)) xcd_barrier(bar); } while (0)
    using pg8::Gemm; using pg8::StaticOrder; using pg8::EpiKV; using pg8::EpiSwiglu; using pg8::EpiRes; using pg8::EpiZ; using pg8::EpiGate; using pg8::EpiQ; using pg8::gemm_phase; using pg8::bf16_t;
    float* const out = args.out;
    bf16_t* const HB = (bf16_t*)(ws + WS_HB);
    float* const ST0 = (float*)(ws + WS_ST0); float* const ST1 = (float*)(ws + WS_ST1); float* const ST2 = (float*)(ws + WS_ST2); float* const ST3 = (float*)(ws + WS_ST3);

    if (IN(0)) { phase_prologue(args, lds, tid, wave, lane, vcu, G); }
    SEAM(0);
    if (IN(1)) {
        Gemm g{(const bf16_t*)(ws + WS_MEMN), (const bf16_t*)(ws + WS_WMKV), MMEM, 2 * DM, DM}; StaticOrder S; S.init(MMEM, 2 * DM, G, bx);
        EpiKV E{out + OFF_MK, out + OFF_MV, (bf16_t*)(ws + WS_KB)};
        gemm_phase<EpiKV, StaticOrder, true, true>(lds, g, S, E);
    }
    if (IN(2)) {
        Gemm g{HB, (const bf16_t*)(ws + WS_W13A), MT, 2 * DFF, DM}; StaticOrder S; S.init(MT, 2 * DFF, G, bx);
        EpiSwiglu E{(bf16_t*)(ws + WS_RACT), ST0};
        gemm_phase<EpiSwiglu, StaticOrder, true, true>(lds, g, S, E);
    }
    SEAM(2);
    if (IN(3)) {
        Gemm g{(const bf16_t*)(ws + WS_RACT), (const bf16_t*)(ws + WS_W2A), MT, DM, DFF}; StaticOrder S; S.init(MT, DM, G, bx);
        EpiRes E{args.in[0], args.in[1], out + OFF_Y, HB, ST1, 0.5f};
        gemm_phase<EpiRes, StaticOrder, true, true>(lds, g, S, E);
    }
    SEAM(3);
    if (IN(4)) {
        Gemm g{HB, (const bf16_t*)(ws + WS_WIN), MT, DIN, DM}; StaticOrder S; S.init(MT, DIN, G, bx);
        EpiZ E{ST1, (bf16_t*)(ws + WS_XA), (bf16_t*)(ws + WS_UU), (bf16_t*)(ws + WS_VV), (bf16_t*)(ws + WS_GATE), (float*)(ws + WS_STV), args.in[12], out + OFF_POOLP, out + OFF_POOLS};
        gemm_phase<EpiZ, StaticOrder, true, true>(lds, g, S, E);
    }
    SEAM(4);
    if (IN(5)) { phase_mixprep(args, lds, tid, wave, lane, vcu, G); }
    SEAM(5);
    if (IN(6)) {
        { Gemm g{(const bf16_t*)(ws + WS_DD), (const bf16_t*)(ws + WS_WA), MT, DM, 512}; StaticOrder S; S.init(MT, DM, G, bx);
          EpiGate<false> E{(const bf16_t*)(ws + WS_GATE), (bf16_t*)(ws + WS_MRG)};
          gemm_phase<EpiGate<false>, StaticOrder, true, true>(lds, g, S, E); }
        { Gemm g{(const bf16_t*)(ws + WS_US), (const bf16_t*)(ws + WS_WPB), MT, DM, 512}; StaticOrder S; S.init(MT, DM, G, bx);
          EpiGate<true> E{(const bf16_t*)(ws + WS_GATE), (bf16_t*)(ws + WS_MRG)};
          gemm_phase<EpiGate<true>, StaticOrder, true, true>(lds, g, S, E); }
    }
    SEAM(6);
    if (IN(7)) {
        Gemm g{(const bf16_t*)(ws + WS_MRG), (const bf16_t*)(ws + WS_WO), MT, DM, DM}; StaticOrder S; S.init(MT, DM, G, bx);
        EpiRes E{out + OFF_Y, out + OFF_Y + (size_t)MP * DM, out + OFF_Y, HB, ST2, 1.0f};
        gemm_phase<EpiRes, StaticOrder, true, true>(lds, g, S, E);
    }
    SEAM(7);
    if (IN(8)) {
        Gemm g{HB, (const bf16_t*)(ws + WS_WQ), MT, DM, DM}; StaticOrder S; S.init(MT, DM, G, bx);
        EpiQ E{ST2, (bf16_t*)(ws + WS_QB), 1.44269504089f * 0.0625f};
        gemm_phase<EpiQ, StaticOrder, true, true>(lds, g, S, E);
    }
    SEAM(8);
    if (IN(9)) { phase_attention(args, lds, wave, lane, vcu, G); }
    SEAM(9);
    if (IN(10)) {
        Gemm g{(const bf16_t*)(ws + WS_OB), (const bf16_t*)(ws + WS_WCO), MT, DM, DM}; StaticOrder S; S.init(MT, DM, G, bx);
        EpiRes E{out + OFF_Y, out + OFF_Y + (size_t)MP * DM, out + OFF_Y, HB, ST3, 1.0f};
        gemm_phase<EpiRes, StaticOrder, true, true>(lds, g, S, E);
    }
    SEAM(10);
    if (IN(11)) {
        Gemm g{HB, (const bf16_t*)(ws + WS_W13B), MT, 2 * DFF, DM}; StaticOrder S; S.init(MT, 2 * DFF, G, bx);
        EpiSwiglu E{(bf16_t*)(ws + WS_RACT), ST3};
        gemm_phase<EpiSwiglu, StaticOrder, true, true>(lds, g, S, E);
    }
    SEAM(11);
    if (IN(12)) {
        Gemm g{(const bf16_t*)(ws + WS_RACT), (const bf16_t*)(ws + WS_W2B), MT, DM, DFF}; StaticOrder S; S.init(MT, DM, G, bx);
        EpiRes E{out + OFF_Y, out + OFF_Y + (size_t)MP * DM, out + OFF_Y, nullptr, nullptr, 0.5f};
        gemm_phase<EpiRes, StaticOrder, true, true>(lds, g, S, E);
    }
    SEAM(12);
    if (IN(13)) { phase_final(args, wave, lane, vcu, G); }
#undef IN
#undef SEAM
}

extern "C" void kernel_launch(void* const* d_in, const int* in_sizes, int n_in, void* d_out, int out_size, void* d_ws, size_t ws_size, hipStream_t stream) {
    static int grid = 0;
    if (grid == 0) {
        if (n_in != 32 || (size_t)out_size != OUT_TOTAL || ws_size < WS_END) { fprintf(stderr, "kernel_launch: unexpected shapes: n_in %d out %d ws %zu (need %zu)\n", n_in, out_size, ws_size, (size_t)WS_END); grid = -1; return; }
        int dev = 0, cus = 0, per_cu = 0;
        if (hipGetDevice(&dev) != hipSuccess || hipDeviceGetAttribute(&cus, hipDeviceAttributeMultiprocessorCount, dev) != hipSuccess) { grid = -1; return; }
        if (hipFuncSetAttribute((const void*)fwd_kernel, hipFuncAttributeMaxDynamicSharedMemorySize, LDS_BYTES) != hipSuccess) { fprintf(stderr, "kernel_launch: hipFuncSetAttribute failed\n"); grid = -1; return; }
        if (hipOccupancyMaxActiveBlocksPerMultiprocessor(&per_cu, (const void*)fwd_kernel, NWAVES * 64, LDS_BYTES) != hipSuccess || per_cu < 1) { fprintf(stderr, "kernel_launch: occupancy query says %d blocks per CU\n", per_cu); grid = -1; (void)hipGetLastError(); return; }
        grid = cus;
    }
    if (grid < 0) return;
    (void)hipMemsetAsync((char*)d_ws + WS_CTL, 0, CTL_ZERO_BYTES, stream);
    Args a{};
    for (int i = 0; i < 32; ++i) a.in[i] = (const float*)d_in[i];
    a.out = (float*)d_out; a.ws = (unsigned char*)d_ws;
#if MK_PER_PHASE
    for (int p = 0; p < N_PHASES; ++p) { a.ph_lo = p; a.ph_hi = p + 1; hipLaunchKernelGGL(fwd_kernel, dim3(grid), dim3(NWAVES * 64), LDS_BYTES, stream, a); }
#else
    a.ph_lo = 0; a.ph_hi = N_PHASES;
    hipLaunchKernelGGL(fwd_kernel, dim3(grid), dim3(NWAVES * 64), LDS_BYTES, stream, a);
#endif
}
```

```cpp
#include <hip/hip_runtime.h>
#include <cstdio>
#include <cstdint>
namespace pg8 {
#define PG8_LAS __attribute__((address_space(3)))
typedef unsigned short bf16_t;
typedef short bf16x8 __attribute__((ext_vector_type(8)));
typedef float f32x4 __attribute__((ext_vector_type(4)));
typedef unsigned u32x4 __attribute__((ext_vector_type(4)));
constexpr int BM = 256, BK = 64, HALF = 128, HTB = HALF * BK * 2  , STAGE_BYTES = 8 * HTB, NXCD = 8, WGM = 8;

__host__ __device__ __forceinline__ int lds_byte(int r, int c) { const int st = (r >> 4) * 2 + (c >> 5), rr = r & 15, cc = c & 31, ob = rr * 64 + cc * 2; return st * 1024 + (ob ^ (((ob >> 9) & 1) << 5)); }
__host__ __device__ __forceinline__ void stage_rc(int b, int& R, int& C) { const int st = b / 1024, sb = b % 1024, swz = sb ^ (((sb >> 9) & 1) << 5); R = (st >> 1) * 16 + swz / 64; C = (st & 1) * 32 + (swz % 64) / 2; }
__host__ __device__ __forceinline__ int perm32(int rho) { const int n = rho >> 4, i = rho & 15; return 8 * (i >> 2) + 4 * n + (i & 3); }

__host__ __device__ __forceinline__ int inv_perm32(int x) { return 16 * ((x >> 2) & 1) + 4 * (x >> 3) + (x & 3); }
__host__ __device__ __forceinline__ int img_off_a(int rin, int c) { return (rin >> 7) * 16384 + lds_byte(rin & 127, c); }
__host__ __device__ __forceinline__ int img_off_w(int rin, int c) { const int r = rin & 127; return (rin >> 7) * 16384 + lds_byte((r & ~31) + inv_perm32(r & 31), c); }
__host__ __device__ __forceinline__ size_t hb_byte(int row, int col) { return (size_t)((row >> 8) * 16 + (col >> 6)) * 32768 + img_off_a(row & 255, col & 63); }
__host__ __device__ __forceinline__ size_t k512_byte(int row, int col) { return (size_t)((row >> 8) * 8 + (col >> 6)) * 32768 + img_off_a(row & 255, col & 63); }
__host__ __device__ __forceinline__ size_t gate_byte(int row, int col) { return (size_t)((row >> 8) * 32 + (col >> 6)) * 32768 + img_off_a(row & 255, col & 63); }
struct Unit { int pm, pn; };
struct Gemm { const bf16_t* A; const bf16_t* Bt; int M, N, K; bool ablk = false; };

struct StaticOrder {
    int nM, nN, nwg, G, c;
    __host__ __device__ void init(int M, int N, int G_, int c_) { nM = M / BM; nN = N / BM; nwg = nM * nN; G = G_; c = c_; }
    __host__ __device__ bool next(int i, Unit& u) const {
        const long L = (long)i * G + c; if (L >= nwg) return false;
        int wgid = (int)L; { const int q = nwg / NXCD, r = nwg % NXCD, xcd = wgid % NXCD, off = wgid / NXCD; wgid = (xcd < r ? xcd * (q + 1) : r * (q + 1) + (xcd - r) * q) + off; }
        const int nig = WGM * nN, gid = wgid / nig, fm = gid * WGM, gsz = (nM - fm) < WGM ? (nM - fm) : WGM;
        u.pm = fm + ((wgid % nig) % gsz); u.pn = (wgid % nig) / gsz; return true;
    }
    __device__ __forceinline__ void a_ready(const Unit&) const {}
    __device__ __forceinline__ void done(const Unit&) const {}
    static constexpr bool HAS_SIG = false;
    __device__ __forceinline__ void signal(int, int) const {}
};
struct DepOrder : StaticOrder {
    static constexpr bool HAS_SIG = true;
    const unsigned* dep; unsigned need; unsigned* sig; unsigned* tmo; int skew = 0; mutable int okpm = -1;
    __device__ bool next(int i, Unit& u) const {
        if (G != 256 || nM != 130) return StaticOrder::next(i, u);
        const int x = c & 7, k = c >> 3, nP = 16 * nN; int li = i * 32 + k;
        if (skew) {
            if (k == 6 && i >= 9) return false;
            if ((k == 17 || k == 18) && i == 11) li = 32 * (9 + (k - 17)) + 6;
        }
        if (li < nP) { const int per = 8 * nN, g = li / per, w = li - g * per; u.pm = 16 * x + 8 * g + (w & 7); u.pn = w >> 3; return true; }
        const int sidx = (li - nP) * 8 + x;
        if (sidx >= 2 * nN) return false;
        u.pm = 128 + (sidx & 1); u.pn = sidx >> 1; return true;
    }
    __device__ __forceinline__ void a_ready(const Unit& u) const {
        if (dep == nullptr || u.pm == okpm) return;
        okpm = u.pm;
        if (threadIdx.x < 64) {
            unsigned polls = 0;
            while ((unsigned)__builtin_amdgcn_readfirstlane(__hip_atomic_load(dep + 64 * u.pm, __ATOMIC_RELAXED, __HIP_MEMORY_SCOPE_AGENT)) < need) {
                if ((++polls & 1023u) == 0u) { if (__builtin_amdgcn_readfirstlane(__hip_atomic_load(tmo, __ATOMIC_RELAXED, __HIP_MEMORY_SCOPE_AGENT)) != 0u) break;
                    if (polls > (1u << 22)) { if (threadIdx.x == 0) __hip_atomic_store(tmo, 1u, __ATOMIC_RELAXED, __HIP_MEMORY_SCOPE_AGENT); break; } }
                __builtin_amdgcn_s_sleep(2); }
            __builtin_amdgcn_fence(__ATOMIC_ACQUIRE, "agent");
            asm volatile("s_waitcnt vmcnt(0)" ::: "memory");
        }
        asm volatile("" ::: "memory"); __builtin_amdgcn_s_barrier(); asm volatile("" ::: "memory");
    }
    __device__ __forceinline__ void signal(int pm, int lane) const { if (sig != nullptr && lane == 0) __hip_atomic_fetch_add(sig + 64 * pm, 1u, __ATOMIC_RELAXED, __HIP_MEMORY_SCOPE_AGENT); }
};

typedef __bf16 bf16x2_t __attribute__((ext_vector_type(2)));
typedef float f32x2_t __attribute__((ext_vector_type(2)));
__device__ __forceinline__ unsigned cvt_pk_bf16(float lo, float hi) { const f32x2_t v = {lo, hi}; const bf16x2_t b = __builtin_convertvector(v, bf16x2_t); return __builtin_bit_cast(unsigned, b); }
typedef float f32x2 __attribute__((ext_vector_type(2)));
constexpr float RMS_EPS = 1e-6f;
__device__ __forceinline__ float fast_sigmoid(float x) { return __builtin_amdgcn_rcpf(1.0f + __builtin_amdgcn_exp2f(-1.44269504089f * x)); }
__device__ __forceinline__ float silu_f(float a) { return a * fast_sigmoid(a); }
__device__ __forceinline__ float gelu_tanh_f(float x) { return x * fast_sigmoid(1.5957691216f * (x + 0.044715f * x * x * x)); }
__device__ __forceinline__ f32x2 sigmoid2(f32x2 x) { const f32x2 t = x * -1.44269504089f; f32x2 e; e.x = __builtin_amdgcn_exp2f(t.x); e.y = __builtin_amdgcn_exp2f(t.y);
    const f32x2 d = e + 1.0f; f32x2 r; r.x = __builtin_amdgcn_rcpf(d.x); r.y = __builtin_amdgcn_rcpf(d.y); return r; }
__device__ __forceinline__ f32x2 gelu_tanh2(f32x2 x) { const f32x2 y = (x * x) * 0.044715f + 1.0f; return x * sigmoid2((y * x) * 1.5957691216f); }
__device__ __forceinline__ float bf_lo(unsigned w) { return __builtin_bit_cast(float, w << 16); }
__device__ __forceinline__ float bf_hi(unsigned w) { return __builtin_bit_cast(float, w & 0xffff0000u); }
__device__ __forceinline__ float row_rinv(const float* st, int row) {
    const f32x4* p = (const f32x4*)(st + (size_t)row * 16);
    const f32x4 a = p[0], b = p[1], c = p[2], d = p[3];
    const float s = (((a.x + a.y) + (a.z + a.w)) + ((b.x + b.y) + (b.z + b.w))) + (((c.x + c.y) + (c.z + c.w)) + ((d.x + d.y) + (d.z + d.w)));
    return __builtin_amdgcn_rsqf(s * (1.0f / 1024.0f) + RMS_EPS);
}
__device__ __forceinline__ void rows_rinv(const float* st, int row0, int fq, float (&r)[2][4]) {
    f32x4 p[2][4];
#pragma unroll
    for (int ai = 0; ai < 2; ++ai)
#pragma unroll
        for (int m = 0; m < 4; ++m) p[ai][m] = *(const f32x4*)(st + (size_t)(row0 + ai * HALF + m * 16) * 16 + 4 * fq);
#pragma unroll
    for (int ai = 0; ai < 2; ++ai)
#pragma unroll
        for (int m = 0; m < 4; ++m) { float s = (p[ai][m].x + p[ai][m].y) + (p[ai][m].z + p[ai][m].w); s += __shfl_xor(s, 16); s += __shfl_xor(s, 32); r[ai][m] = __builtin_amdgcn_rsqf(s * (1.0f / 1024.0f) + RMS_EPS); }
}
__device__ __forceinline__ u32x4 pack8(const float (&o)[8]) { u32x4 w; w.x = cvt_pk_bf16(o[0], o[1]); w.y = cvt_pk_bf16(o[2], o[3]); w.z = cvt_pk_bf16(o[4], o[5]); w.w = cvt_pk_bf16(o[6], o[7]); return w; }

__device__ __forceinline__ void store16_sel(void* p, u32x4 v, bool wt) { if (wt) asm volatile("global_store_dwordx4 %0, %1, off sc1\n\ts_nop 1" :: "v"(p), "v"(v) : "memory"); else *(u32x4*)p = v; }
__device__ __forceinline__ void store16_wt(void* p, u32x4 v) { asm volatile("global_store_dwordx4 %0, %1, off sc1\n\ts_nop 1" :: "v"(p), "v"(v) : "memory"); }
struct EpiSwiglu {
    static constexpr bool PERM = true, AFTER_DRAIN = false;
    bf16_t* O; const float* st; bool wtall;
    __device__ __forceinline__ void operator()(const f32x4 (&acc)[2][2][4][2], const Unit& u, int wr, int wc, int fr_, int fq_) const {
        int fr = fr_, fq = fq_; asm volatile("" : "+v"(fr), "+v"(fq));
        const int row0 = u.pm * BM + wr * 64 + fr;
        unsigned char* const Ob = (unsigned char*)O + (size_t)(u.pm * (2816 / 64) + u.pn * 2 + (wc >> 1)) * 32768;
        float rr[2][4]; rows_rinv(st, row0, fq, rr);
#pragma unroll
        for (int ai = 0; ai < 2; ++ai)
#pragma unroll
            for (int m = 0; m < 4; ++m) {
                const int row = row0 + ai * HALF + m * 16;
                const float r = rr[ai][m];
                float o[8];
#pragma unroll
                for (int n = 0; n < 2; ++n)
#pragma unroll
                    for (int j = 0; j < 4; j += 2) { const f32x2 a = (f32x2){acc[ai][0][m][n][j], acc[ai][0][m][n][j + 1]} * r, b = (f32x2){acc[ai][1][m][n][j], acc[ai][1][m][n][j + 1]} * r;
                        const f32x2 v = (a * sigmoid2(a)) * b; o[n * 4 + j] = v.x; o[n * 4 + j + 1] = v.y; }
                store16_sel(Ob + img_off_a(wr * 64 + fr + ai * HALF + m * 16, (wc & 1) * 32 + 8 * fq), pack8(o), wtall || u.pm >= 128);
                asm volatile("" ::: "memory");
            }
    }
};
template <bool FINAL> struct EpiRes {
    static constexpr bool PERM = true, AFTER_DRAIN = false;
    bf16_t* hb; float* st; float* out; float scale; bool wtall;
    __device__ __forceinline__ void operator()(const f32x4 (&acc)[2][2][4][2], const Unit& u, int wr, int wc, int fr_, int fq_) const {
        int fr = fr_, fq = fq_; asm volatile("" : "+v"(fr), "+v"(fq));
        const int row0 = u.pm * BM + wr * 64 + fr, col0 = u.pn * BM + wc * 32 + 8 * fq;
#pragma unroll
        for (int ai = 0; ai < 2; ++ai) {
            u32x4 hv[4][2];
#pragma unroll
            for (int m = 0; m < 4; ++m)
#pragma unroll
                for (int bj = 0; bj < 2; ++bj) hv[m][bj] = *(const u32x4*)((const unsigned char*)hb + hb_byte(row0 + ai * HALF + m * 16, col0 + bj * HALF));
#pragma unroll
            for (int m = 0; m < 4; ++m) {
                const int row = row0 + ai * HALF + m * 16;
                float ss = 0.f;
#pragma unroll
                for (int bj = 0; bj < 2; ++bj) {
                    bf16_t* hp = (bf16_t*)((unsigned char*)hb + hb_byte(row, col0 + bj * HALF));
                    const u32x4 b = hv[m][bj];
                    f32x4 v0 = acc[ai][bj][m][0] * scale, v1 = acc[ai][bj][m][1] * scale;
                    v0.x += bf_lo(b.x); v0.y += bf_hi(b.x); v0.z += bf_lo(b.y); v0.w += bf_hi(b.y); v1.x += bf_lo(b.z); v1.y += bf_hi(b.z); v1.z += bf_lo(b.w); v1.w += bf_hi(b.w);
                    if (FINAL) { float* op = out + (size_t)row * 1024 + col0 + bj * HALF; *(f32x4*)op = v0; *(f32x4*)(op + 4) = v1; }
                    else { u32x4 w; w.x = cvt_pk_bf16(v0.x, v0.y); w.y = cvt_pk_bf16(v0.z, v0.w); w.z = cvt_pk_bf16(v1.x, v1.y); w.w = cvt_pk_bf16(v1.z, v1.w); store16_sel(hp, w, wtall || u.pm >= 128);
                        ss += ((v0.x * v0.x + v0.y * v0.y) + (v0.z * v0.z + v0.w * v0.w)) + ((v1.x * v1.x + v1.y * v1.y) + (v1.z * v1.z + v1.w * v1.w)); }
                }
                if (!FINAL) { ss += __shfl_xor(ss, 16); ss += __shfl_xor(ss, 32); if (fq == 0) __hip_atomic_store(st + (size_t)row * 16 + u.pn * 4 + wc, ss, __ATOMIC_RELAXED, __HIP_MEMORY_SCOPE_AGENT); }
            }
            asm volatile("" ::: "memory");
        }
    }
};
struct EpiZ {
    static constexpr bool PERM = true, AFTER_DRAIN = false;
    const float* st; bf16_t* xa; bf16_t* uu; bf16_t* vv; bf16_t* gate; float* stv; const float* b_gate; float* poolp; float* pools; int pn_off; bool wtall;
    __device__ __forceinline__ void operator()(const f32x4 (&acc)[2][2][4][2], const Unit& u, int wr, int wc, int fr_, int fq_) const {
        int fr = fr_, fq = fq_; asm volatile("" : "+v"(fr), "+v"(fq));
        const int row0 = u.pm * BM + wr * 64 + fr; const int pn = u.pn + pn_off;
        const int kind = pn < 2 ? 0 : (pn < 4 ? 1 : (pn < 6 ? 2 : 3));
        const int tbase = pn < 2 ? 0 : (pn < 4 ? 2 : (pn < 6 ? 4 : 6));
        const int lc0 = (pn - tbase) * BM + wc * 32 + 8 * fq;
        float rr[2][4]; rows_rinv(st, row0, fq, rr);
        if (kind == 0) {
#pragma unroll
            for (int ai = 0; ai < 2; ++ai)
#pragma unroll
                for (int m = 0; m < 4; ++m) {
                    const int row = row0 + ai * HALF + m * 16; const float r = rr[ai][m];
                    float* pdst = nullptr;
                    if (row < 32768) { const int t = row & 4095; if (t >= 4081) pdst = poolp + (size_t)((row >> 12) * 15 + (t - 4081)) * 512; }
                    else { const int sr = row - 32768, t = sr & 15; if (t >= 1) pdst = pools + (size_t)((sr >> 4) * 15 + (t - 1)) * 512; }
#pragma unroll
                    for (int bj = 0; bj < 2; ++bj) {
                        const f32x4 v0 = acc[ai][bj][m][0] * r, v1 = acc[ai][bj][m][1] * r; const int c = lc0 + bj * HALF;
                        u32x4 w; w.x = cvt_pk_bf16(v0.x, v0.y); w.y = cvt_pk_bf16(v0.z, v0.w); w.z = cvt_pk_bf16(v1.x, v1.y); w.w = cvt_pk_bf16(v1.z, v1.w);
                        *(u32x4*)(xa + (size_t)row * 512 + c) = w;
                        if (pdst) { *(f32x4*)(pdst + c) = v0; *(f32x4*)(pdst + c + 4) = v1; }
                    }
                }
        } else if (kind == 1) {
#pragma unroll
            for (int ai = 0; ai < 2; ++ai)
#pragma unroll
                for (int m = 0; m < 4; ++m) {
                    const int row = row0 + ai * HALF + m * 16; const float r = rr[ai][m];
#pragma unroll
                    for (int bj = 0; bj < 2; ++bj) {
                        float o[8];
#pragma unroll
                        for (int n = 0; n < 2; ++n)
#pragma unroll
                            for (int j = 0; j < 4; j += 2) { const f32x2 v = gelu_tanh2((f32x2){acc[ai][bj][m][n][j], acc[ai][bj][m][n][j + 1]} * r); o[n * 4 + j] = v.x; o[n * 4 + j + 1] = v.y; }
                        *(u32x4*)(uu + (size_t)row * 512 + lc0 + bj * HALF) = pack8(o);
                    }
                }
        } else if (kind == 2) {
#pragma unroll
            for (int ai = 0; ai < 2; ++ai)
#pragma unroll
                for (int m = 0; m < 4; ++m) {
                    const int row = row0 + ai * HALF + m * 16; const float r = rr[ai][m];
                    float s1 = 0.f, s2 = 0.f;
#pragma unroll
                    for (int bj = 0; bj < 2; ++bj) {
                        float o[8];
#pragma unroll
                        for (int n = 0; n < 2; ++n)
#pragma unroll
                            for (int j = 0; j < 4; j += 2) { const f32x2 g = gelu_tanh2((f32x2){acc[ai][bj][m][n][j], acc[ai][bj][m][n][j + 1]} * r); o[n * 4 + j] = g.x; o[n * 4 + j + 1] = g.y; s1 += g.x + g.y; s2 += g.x * g.x + g.y * g.y; }
                        *(u32x4*)(vv + (size_t)row * 512 + lc0 + bj * HALF) = pack8(o);
                    }
                    s1 += __shfl_xor(s1, 16); s1 += __shfl_xor(s1, 32); s2 += __shfl_xor(s2, 16); s2 += __shfl_xor(s2, 32);
                    if (fq == 0) { f32x2 sv; sv.x = s1; sv.y = s2; *(f32x2*)(stv + (size_t)row * 16 + ((pn - 4) * 4 + wc) * 2) = sv; }
                }
        } else {
            f32x4 bv[2][2];
#pragma unroll
            for (int bj = 0; bj < 2; ++bj)
#pragma unroll
                for (int n = 0; n < 2; ++n) bv[bj][n] = *(const f32x4*)(b_gate + lc0 + bj * HALF + 4 * n);
#pragma unroll
            for (int ai = 0; ai < 2; ++ai)
#pragma unroll
                for (int m = 0; m < 4; ++m) {
                    const int row = row0 + ai * HALF + m * 16; const float r = rr[ai][m];
#pragma unroll
                    for (int bj = 0; bj < 2; ++bj) {
                        float o[8];
#pragma unroll
                        for (int n = 0; n < 2; ++n)
#pragma unroll
                            for (int j = 0; j < 4; j += 2) { const f32x2 v = sigmoid2((f32x2){acc[ai][bj][m][n][j], acc[ai][bj][m][n][j + 1]} * r + (f32x2){bv[bj][n][j], bv[bj][n][j + 1]}); o[n * 4 + j] = v.x; o[n * 4 + j + 1] = v.y; }
                        store16_sel((unsigned char*)gate + gate_byte(row, lc0 + bj * HALF), pack8(o), wtall || u.pm >= 128);
                    }
                }
        }
    }
};
template <bool ADD> struct EpiGate {
    static constexpr bool PERM = true, AFTER_DRAIN = false;
    const bf16_t* gate; bf16_t* mrg; bool wtall;
    __device__ __forceinline__ void operator()(const f32x4 (&acc)[2][2][4][2], const Unit& u, int wr, int wc, int fr_, int fq_) const {
        int fr = fr_, fq = fq_; asm volatile("" : "+v"(fr), "+v"(fq));
        const int row0 = u.pm * BM + wr * 64 + fr, col0 = u.pn * BM + wc * 32 + 8 * fq;
#pragma unroll
        for (int ai = 0; ai < 2; ++ai)
#pragma unroll
            for (int mp = 0; mp < 2; ++mp) {
                u32x4 gv[2][2], tv[2][2];
#pragma unroll
                for (int mm = 0; mm < 2; ++mm)
#pragma unroll
                    for (int bj = 0; bj < 2; ++bj) { const int row = row0 + ai * HALF + (2 * mp + mm) * 16, c = col0 + bj * HALF;
                        gv[mm][bj] = *(const u32x4*)((const unsigned char*)gate + gate_byte(row, (ADD ? 1024 : 0) + c));
                        if (ADD) tv[mm][bj] = *(const u32x4*)((const unsigned char*)mrg + hb_byte(row, c)); }
#pragma unroll
                for (int mm = 0; mm < 2; ++mm) {
                    const int m = 2 * mp + mm; const int row = row0 + ai * HALF + m * 16;
#pragma unroll
                    for (int bj = 0; bj < 2; ++bj) {
                        const int c = col0 + bj * HALF;
                        const u32x4 g = gv[mm][bj];
                        float o[8];
                        o[0] = acc[ai][bj][m][0].x * bf_lo(g.x); o[1] = acc[ai][bj][m][0].y * bf_hi(g.x); o[2] = acc[ai][bj][m][0].z * bf_lo(g.y); o[3] = acc[ai][bj][m][0].w * bf_hi(g.y);
                        o[4] = acc[ai][bj][m][1].x * bf_lo(g.z); o[5] = acc[ai][bj][m][1].y * bf_hi(g.z); o[6] = acc[ai][bj][m][1].z * bf_lo(g.w); o[7] = acc[ai][bj][m][1].w * bf_hi(g.w);
                        bf16_t* mpt = (bf16_t*)((unsigned char*)mrg + hb_byte(row, c));
                        if (ADD) { const u32x4 t = tv[mm][bj];
                            o[0] += bf_lo(t.x); o[1] += bf_hi(t.x); o[2] += bf_lo(t.y); o[3] += bf_hi(t.y); o[4] += bf_lo(t.z); o[5] += bf_hi(t.z); o[6] += bf_lo(t.w); o[7] += bf_hi(t.w); }
                        if (ADD) store16_sel(mpt, pack8(o), wtall || u.pm >= 128); else *(u32x4*)mpt = pack8(o);
                    }
                }
                asm volatile("" ::: "memory");
            }
    }
};
struct EpiQ {
    static constexpr bool PERM = true, AFTER_DRAIN = false;
    const float* st; bf16_t* q; float qscale;
    __device__ __forceinline__ void operator()(const f32x4 (&acc)[2][2][4][2], const Unit& u, int wr, int wc, int fr_, int fq_) const {
        int fr = fr_, fq = fq_; asm volatile("" : "+v"(fr), "+v"(fq));
        const int row0 = u.pm * BM + wr * 64 + fr, col0 = u.pn * BM + wc * 32 + 8 * fq;
        float rr[2][4]; rows_rinv(st, row0, fq, rr);
#pragma unroll
        for (int ai = 0; ai < 2; ++ai)
#pragma unroll
            for (int m = 0; m < 4; ++m) {
                const int row = row0 + ai * HALF + m * 16; const float r = rr[ai][m] * qscale;
#pragma unroll
                for (int bj = 0; bj < 2; ++bj) {
                    const f32x4 v0 = acc[ai][bj][m][0] * r, v1 = acc[ai][bj][m][1] * r;
                    u32x4 w; w.x = cvt_pk_bf16(v0.x, v0.y); w.y = cvt_pk_bf16(v0.z, v0.w); w.z = cvt_pk_bf16(v1.x, v1.y); w.w = cvt_pk_bf16(v1.z, v1.w);
                    *(u32x4*)((unsigned char*)q + hb_byte(row, col0 + bj * HALF)) = w;
                }
            }
    }
};
struct EpiKV {
    static constexpr bool PERM = true, AFTER_DRAIN = false;
    float* out_k; float* out_v; bf16_t* kb;
    __device__ __forceinline__ void operator()(const f32x4 (&acc)[2][2][4][2], const Unit& u, int wr, int wc, int fr_, int fq_) const {
        int fr = fr_, fq = fq_; asm volatile("" : "+v"(fr), "+v"(fq));
        const int row0 = u.pm * BM + wr * 64 + fr; const bool isk = u.pn < 4;
        const int col0 = (isk ? u.pn : u.pn - 4) * BM + wc * 32 + 8 * fq; float* of = isk ? out_k : out_v;
#pragma unroll
        for (int ai = 0; ai < 2; ++ai)
#pragma unroll
            for (int m = 0; m < 4; ++m) {
                const int row = row0 + ai * HALF + m * 16;
#pragma unroll
                for (int bj = 0; bj < 2; ++bj) {
                    const f32x4 v0 = acc[ai][bj][m][0], v1 = acc[ai][bj][m][1]; const int c = col0 + bj * HALF;
                    float* op = of + (size_t)row * 1024 + c; if (isk) { __builtin_nontemporal_store(v0, (f32x4*)op); __builtin_nontemporal_store(v1, (f32x4*)(op + 4)); } else { *(f32x4*)op = v0; *(f32x4*)(op + 4) = v1; }
                    if (isk) { u32x4 w; w.x = cvt_pk_bf16(v0.x, v0.y); w.y = cvt_pk_bf16(v0.z, v0.w); w.z = cvt_pk_bf16(v1.x, v1.y); w.w = cvt_pk_bf16(v1.z, v1.w); *(u32x4*)(kb + (size_t)row * 1024 + c) = w; }
                }
            }
    }
};

__device__ __forceinline__ void glds16x2_sv(const void* sbase, unsigned voff0, unsigned voff1, unsigned lds_dst) {
    unsigned keep;
    asm volatile("s_mov_b32 %0, m0\n\ts_mov_b32 m0, %4\n\ts_nop 0\n\tglobal_load_lds_dwordx4 %1, %3\n\ts_add_u32 m0, %4, 0x2000\n\ts_nop 0\n\tglobal_load_lds_dwordx4 %2, %3\n\ts_mov_b32 m0, %0"
                 : "=&s"(keep) : "v"(voff0), "v"(voff1), "s"(sbase), "s"(lds_dst) : "memory", "scc");
}
template <class Epi, class Sched, bool ALIGN_EPI = false, bool SP2 = false>
__device__ __forceinline__ void gemm_phase(PG8_LAS unsigned char* lds, const Gemm g, const Sched& S, const Epi& E) {
    const int tid = threadIdx.x, wid = __builtin_amdgcn_readfirstlane(tid >> 6), lane = tid & 63, wr = wid >> 2, wc = wid & 3, fr = lane & 15, fq = lane >> 4;
    const int K = g.K, nt = K / BK;
    unsigned voffA[2], voffB[2];
#pragma unroll
    for (int i = 0; i < 2; ++i) { int R, C; stage_rc(tid * 16 + i * 8192, R, C); const int Rb = Epi::PERM ? ((R & ~31) + perm32(R & 31)) : R;
        voffA[i] = g.ablk ? (unsigned)(tid * 16 + i * 8192) : (unsigned)(R * K + C) * 2u; voffB[i] = (unsigned)(tid * 16 + i * 8192); (void)Rb; }
    const size_t kstep = (size_t)(BK * 2);
    const size_t hstep = (size_t)HALF * K * 2;
    const size_t tstep = 2 * hstep;
    const size_t bkstep = (size_t)(BM * BK * 2), bhstep = (size_t)(HALF * BK * 2), btstep = (size_t)nt * (BM * BK * 2);
    const size_t akstep = g.ablk ? (size_t)(BM * BK * 2) : kstep, ahstep = g.ablk ? (size_t)(HALF * BK * 2) : hstep, atstep = g.ablk ? (size_t)nt * (BM * BK * 2) : tstep;
    const unsigned ldsw = (unsigned)wid * 1024u;
    const unsigned ldsb = (unsigned)__builtin_amdgcn_readfirstlane((int)((unsigned)(size_t)lds + ldsw));
    const int aoff = lds_byte(wr * 64 + fr, fq * 8), boff = lds_byte(wc * 32 + fr, fq * 8);
#define PG8_SA(b, h) (((b) * 2 + (h)) * HTB)
#define PG8_SB(b, h) ((4 + (b) * 2 + (h)) * HTB)
#define PG8_STAGE(bufoff, gbase, voff) glds16x2_sv((const void*)(gbase), (voff)[0], (voff)[1], ldsb + (unsigned)(bufoff))
#define PG8_LDA(dst, b, h) do { _Pragma("unroll") for (int m = 0; m < 4; ++m) _Pragma("unroll") for (int k = 0; k < 2; ++k) dst[m][k] = *(const PG8_LAS bf16x8*)(lds + PG8_SA(b, h) + aoff + m * 2048 + k * 1024); } while (0)
#define PG8_LDB(dst, b, h) do { _Pragma("unroll") for (int n = 0; n < 2; ++n) _Pragma("unroll") for (int k = 0; k < 2; ++k) dst[n][k] = *(const PG8_LAS bf16x8*)(lds + PG8_SB(b, h) + boff + n * 2048 + k * 1024); } while (0)
#define PG8_MMA(ai, bj, At, Bt) do { __builtin_amdgcn_s_setprio(1); _Pragma("unroll") for (int m = 0; m < 4; ++m) _Pragma("unroll") for (int n = 0; n < 2; ++n) _Pragma("unroll") for (int k = 0; k < 2; ++k) \
        acc[ai][bj][m][n] = __builtin_amdgcn_mfma_f32_16x16x32_bf16(Bt[n][k], At[m][k], acc[ai][bj][m][n], 0, 0, 0); __builtin_amdgcn_s_setprio(0); } while (0)
#define PG8_ZERO(ai) do { if (t == 0) { _Pragma("unroll") for (int b = 0; b < 2; ++b) _Pragma("unroll") for (int m = 0; m < 4; ++m) _Pragma("unroll") for (int n = 0; n < 2; ++n) acc[ai][b][m][n] = (f32x4){0.f, 0.f, 0.f, 0.f}; } } while (0)
#define PG8_WAIT_V(n) asm volatile("s_waitcnt vmcnt(" #n ")" ::: "memory")
#define PG8_WAIT_L(n) asm volatile("s_waitcnt lgkmcnt(" #n ")" ::: "memory")
#define PG8_BAR __builtin_amdgcn_s_barrier()
#define PG8_SCHED __builtin_amdgcn_sched_barrier(0)
    Unit cur, nxt; int ui = 0; int pend = -1;
    if (!S.next(0, cur)) return;
    f32x4 acc[2][2][4][2];
#pragma unroll
    for (int a = 0; a < 2; ++a)
#pragma unroll
        for (int b = 0; b < 2; ++b)
#pragma unroll
            for (int m = 0; m < 4; ++m)
#pragma unroll
                for (int n = 0; n < 2; ++n) acc[a][b][m][n] = (f32x4){0.f, 0.f, 0.f, 0.f};
    bf16x8 At[4][2], B0[2][2], B1[2][2];
    const char* cA = (const char*)g.A + (size_t)cur.pm * atstep; const char* cB = (const char*)g.Bt + (size_t)cur.pn * btstep;
    S.a_ready(cur);
    if constexpr (SP2) {
        PG8_STAGE(PG8_SB(0, 0), cB, voffB); PG8_STAGE(PG8_SB(0, 1), cB + bhstep, voffB); PG8_STAGE(PG8_SA(0, 0), cA, voffA); PG8_STAGE(PG8_SA(0, 1), cA + ahstep, voffA);
        if (wr == 1) PG8_BAR;
        PG8_WAIT_V(2); PG8_BAR;
        PG8_STAGE(PG8_SB(1, 0), cB + bkstep, voffB); PG8_STAGE(PG8_SA(1, 0), cA + akstep, voffA); PG8_STAGE(PG8_SB(1, 1), cB + bhstep + bkstep, voffB);
        PG8_WAIT_V(6); PG8_BAR;
    } else {
        PG8_STAGE(PG8_SB(0, 0), cB, voffB); PG8_STAGE(PG8_SA(0, 0), cA, voffA); PG8_STAGE(PG8_SB(0, 1), cB + bhstep, voffB); PG8_STAGE(PG8_SA(0, 1), cA + ahstep, voffA);
        if (wr == 1) PG8_BAR;
        PG8_WAIT_V(4); PG8_BAR;
        PG8_STAGE(PG8_SB(1, 0), cB + bkstep, voffB); PG8_STAGE(PG8_SA(1, 0), cA + akstep, voffA); PG8_STAGE(PG8_SB(1, 1), cB + bhstep + bkstep, voffB);
        PG8_WAIT_V(6); PG8_BAR;
    }
    for (;;) {
        const bool has_next = S.next(ui + 1, nxt);
        const char* nA = has_next ? (const char*)g.A + (size_t)nxt.pm * atstep : cA; const char* nB = has_next ? (const char*)g.Bt + (size_t)nxt.pn * btstep : cB;
        for (int t = 0; t < nt; t += 2) {
            const bool last = (t == nt - 2);
            if constexpr (Sched::HAS_SIG) { if (t == 2 && pend >= 0) { S.signal(pend, lane); pend = -1; } }
            const char* a1 = cA + (size_t)(t + 1) * akstep;
            const char* a2 = last ? nA : cA + (size_t)(t + 2) * akstep; const char* b2 = last ? nB : cB + (size_t)(t + 2) * bkstep;
            const char* a3 = a2 + akstep; const char* b3 = b2 + bkstep;
            if (last && has_next) S.a_ready(nxt);
            if constexpr (SP2) {
            PG8_LDB(B0, 0, 0); PG8_LDB(B1, 0, 1); PG8_SCHED; PG8_LDA(At, 0, 0); PG8_STAGE(PG8_SA(1, 1), a1 + ahstep, voffA); PG8_ZERO(0);
            PG8_WAIT_V(8); PG8_WAIT_L(0); PG8_BAR; PG8_MMA(0, 0, At, B0); PG8_MMA(0, 1, At, B1); PG8_BAR; PG8_SCHED;
            PG8_LDA(At, 0, 1); PG8_STAGE(PG8_SB(0, 0), b2, voffB); PG8_STAGE(PG8_SB(0, 1), b2 + bhstep, voffB); PG8_STAGE(PG8_SA(0, 0), a2, voffA); PG8_ZERO(1);
            PG8_WAIT_V(8); PG8_WAIT_L(0); PG8_BAR; PG8_MMA(1, 0, At, B0); PG8_MMA(1, 1, At, B1); PG8_BAR; PG8_SCHED;
            PG8_LDB(B0, 1, 0); PG8_LDB(B1, 1, 1); PG8_SCHED; PG8_LDA(At, 1, 0); PG8_STAGE(PG8_SA(0, 1), a2 + ahstep, voffA);
            PG8_WAIT_V(8); PG8_WAIT_L(0); PG8_BAR; PG8_MMA(0, 0, At, B0); PG8_MMA(0, 1, At, B1); PG8_BAR; PG8_SCHED;
            PG8_LDA(At, 1, 1); PG8_STAGE(PG8_SB(1, 0), b3, voffB); PG8_STAGE(PG8_SB(1, 1), b3 + bhstep, voffB); PG8_STAGE(PG8_SA(1, 0), a3, voffA);
            PG8_WAIT_V(8); PG8_WAIT_L(0); PG8_BAR; PG8_MMA(1, 0, At, B0); PG8_MMA(1, 1, At, B1); PG8_BAR; PG8_SCHED;
            } else {
            PG8_LDB(B0, 0, 0); PG8_SCHED; PG8_LDA(At, 0, 0); PG8_STAGE(PG8_SA(1, 1), a1 + ahstep, voffA);
            PG8_WAIT_L(8); PG8_BAR; PG8_WAIT_L(0); PG8_MMA(0, 0, At, B0); PG8_BAR; PG8_SCHED;
            PG8_LDB(B1, 0, 1); PG8_STAGE(PG8_SB(0, 0), b2, voffB);
            PG8_BAR; PG8_WAIT_L(0); PG8_MMA(0, 1, At, B1); PG8_BAR;
            PG8_LDA(At, 0, 1); PG8_STAGE(PG8_SA(0, 0), a2, voffA);
            PG8_BAR; PG8_WAIT_L(0); PG8_MMA(1, 0, At, B0); PG8_BAR; PG8_SCHED;
            PG8_STAGE(PG8_SB(0, 1), b2 + bhstep, voffB);
            PG8_WAIT_V(6); PG8_BAR; PG8_MMA(1, 1, At, B1); PG8_BAR;
            PG8_LDB(B0, 1, 0); PG8_SCHED; PG8_LDA(At, 1, 0); PG8_STAGE(PG8_SA(0, 1), a2 + ahstep, voffA);
            PG8_WAIT_L(8); PG8_BAR; PG8_WAIT_L(0); PG8_MMA(0, 0, At, B0); PG8_BAR; PG8_SCHED;
            PG8_LDB(B1, 1, 1); PG8_STAGE(PG8_SB(1, 0), b3, voffB);
            PG8_BAR; PG8_WAIT_L(0); PG8_MMA(0, 1, At, B1); PG8_BAR;
            PG8_LDA(At, 1, 1); PG8_STAGE(PG8_SA(1, 0), a3, voffA);
            PG8_BAR; PG8_WAIT_L(0); PG8_MMA(1, 0, At, B0); PG8_BAR; PG8_SCHED;
            PG8_STAGE(PG8_SB(1, 1), b3 + bhstep, voffB);
            PG8_WAIT_V(6); PG8_BAR; PG8_MMA(1, 1, At, B1); PG8_BAR;
            }
        }
        if constexpr (ALIGN_EPI) { if (wr == 0) PG8_BAR; }
        if constexpr (!Epi::AFTER_DRAIN) { E(acc, cur, wr, wc, fr, fq); S.done(cur); }
        if constexpr (Sched::HAS_SIG) pend = cur.pm;
        if (!has_next) break;
        if constexpr (!SP2) {
#pragma unroll
        for (int a = 0; a < 2; ++a)
#pragma unroll
            for (int b = 0; b < 2; ++b)
#pragma unroll
                for (int m = 0; m < 4; ++m)
#pragma unroll
                    for (int n = 0; n < 2; ++n) acc[a][b][m][n] = (f32x4){0.f, 0.f, 0.f, 0.f};
        }
        cur = nxt; cA = nA; cB = nB; ++ui;
        if constexpr (ALIGN_EPI) { if (wr == 1) PG8_BAR; }
    }
    PG8_WAIT_V(0);
    if constexpr (Sched::HAS_SIG) { if (pend >= 0) { S.signal(pend, lane); pend = -1; } }
    if constexpr (!ALIGN_EPI) { if (wr == 0) PG8_BAR; }
    PG8_BAR;
    if constexpr (Epi::AFTER_DRAIN) { E.fused(acc, cur, wr, wc, fr, fq, lds, wid, lane); S.done(cur); }
#undef PG8_SA
#undef PG8_SB
#undef PG8_STAGE
#undef PG8_LDA
#undef PG8_LDB
#undef PG8_MMA
#undef PG8_WAIT_V
#undef PG8_ZERO
#undef PG8_WAIT_L
#undef PG8_BAR
#undef PG8_SCHED
}
}
#define GAS __attribute__((address_space(1)))
#define LAS __attribute__((address_space(3)))
typedef unsigned short bf16;
typedef unsigned v4u __attribute__((ext_vector_type(4)));
typedef float f32x4 __attribute__((ext_vector_type(4)));
typedef short bf16x8 __attribute__((ext_vector_type(8)));
typedef GAS unsigned gu32;
typedef GAS unsigned long long gu64;
#define RLX_AGENT __ATOMIC_RELAXED, __HIP_MEMORY_SCOPE_AGENT
#define LDS_WAIT() asm volatile("s_waitcnt lgkmcnt(0)" ::: "memory")
#define VM_WAIT() asm volatile("s_waitcnt vmcnt(0)" ::: "memory")
__device__ __forceinline__ unsigned long long rt() { return __builtin_amdgcn_s_memrealtime(); }
__device__ __forceinline__ unsigned f2bf(float f) { unsigned u = __builtin_bit_cast(unsigned, f); return (u + 0x7fffu + ((u >> 16) & 1u)) >> 16; }
__device__ __forceinline__ unsigned pk2(float lo, float hi) { return f2bf(lo) | (f2bf(hi) << 16); }

#define XB_TMO      128
#define XB_XCNT(j)  (256  + 64 * (j))
#define XB_XSUB(j)  (1280 + 64 * (j))
#define XB_XGEN(j)  (2304 + 64 * (j))
#define XB_TOP      3328
#define XB_TOPGEN   3392
#define XCD_BAR_WORDS 3456
#define XB_SPIN_CAP (1u << 18)

__device__ __forceinline__ unsigned xb_ld(unsigned* p)              { return __hip_atomic_load(p, __ATOMIC_RELAXED, __HIP_MEMORY_SCOPE_AGENT); }
__device__ __forceinline__ unsigned xb_add(unsigned* p, unsigned v) { return __hip_atomic_fetch_add(p, v, __ATOMIC_RELAXED, __HIP_MEMORY_SCOPE_AGENT); }
__device__ __forceinline__ unsigned xb_xcc_id() { return (unsigned)__builtin_amdgcn_s_getreg((3 << 11) | 20) & 0xFu; }
#define XB_SPIN(cond, bar) do { unsigned _sp = 0; while (cond) { __builtin_amdgcn_s_sleep(1); \
    if ((++_sp & 255u) == 0u) { if (xb_ld(&(bar)[XB_TMO])) break; if (_sp > XB_SPIN_CAP) { atomicAdd(&(bar)[XB_TMO], 1u); break; } } } } while (0)

struct XcdBarrier {
    unsigned* bar; unsigned x;
    volatile LAS unsigned* st;
};

__device__ __forceinline__ XcdBarrier xcd_barrier_post(unsigned* bar, volatile LAS unsigned* st) {
    XcdBarrier b; b.bar = bar; b.x = xb_xcc_id(); b.st = st;
    if (threadIdx.x == 0) (void)xb_add(&bar[XB_XCNT(b.x)], 1u);
    return b;
}
__device__ __forceinline__ void xcd_barrier_complete(unsigned* bar, unsigned x, unsigned& nloc, unsigned& nx) {
    const unsigned G = gridDim.x * gridDim.y * gridDim.z;
    unsigned sum, cnt, mine, sp = 0u;
    for (;;) {
        sum = 0u; cnt = 0u; mine = 0u;
#pragma unroll
        for (unsigned j = 0; j < 16; ++j) { const unsigned c = xb_ld(&bar[XB_XCNT(j)]); sum += c; cnt += (c > 0u) ? 1u : 0u; mine = (j == x) ? c : mine; }
        if (sum == G) break;
        __builtin_amdgcn_s_sleep(1);
        if ((++sp & 255u) == 0u) { if (xb_ld(&bar[XB_TMO])) break; if (sp > XB_SPIN_CAP) { atomicAdd(&bar[XB_TMO], 1u); break; } }
    }
    nloc = mine > 0u ? mine : 1u; nx = cnt > 0u ? cnt : 1u;
}

__device__ __forceinline__ void xcd_barrier(const XcdBarrier& b) {
    asm volatile("s_waitcnt vmcnt(0)" ::: "memory");
    __syncthreads();
    if (threadIdx.x == 0) {
        unsigned* bar = b.bar;
        __builtin_amdgcn_s_waitcnt(0);
        unsigned nloc = b.st[0], nx = b.st[1];
        if (nloc == 0u) { xcd_barrier_complete(bar, b.x, nloc, nx); b.st[0] = nloc; b.st[1] = nx; }
        const unsigned old = xb_add(&bar[XB_XSUB(b.x)], 1u);
        const unsigned gen = old / nloc;
        if (old + 1u == (gen + 1u) * nloc) {
            __builtin_amdgcn_fence(__ATOMIC_RELEASE, "agent");
            asm volatile("s_waitcnt vmcnt(0)" ::: "memory");
            const unsigned og = xb_add(&bar[XB_TOP], 1u);
            const unsigned tg = og / nx;
            if (og + 1u == (tg + 1u) * nx) xb_add(&bar[XB_TOPGEN], 1u);
            else XB_SPIN(xb_ld(&bar[XB_TOPGEN]) == tg, bar);
            __builtin_amdgcn_fence(__ATOMIC_ACQUIRE, "agent");
            xb_add(&bar[XB_XGEN(b.x)], 1u);
            asm volatile("s_waitcnt vmcnt(0)" ::: "memory");
        } else {
            XB_SPIN(xb_ld(&bar[XB_XGEN(b.x)]) == gen, bar);
            __builtin_amdgcn_fence(__ATOMIC_ACQUIRE, "agent");
            asm volatile("s_waitcnt vmcnt(0)" ::: "memory");
        }
    }
    __syncthreads();
}
using pg8::bf_lo; using pg8::bf_hi;
constexpr int DM = 1024, MP = 8 * 4096, MS = 32 * 16, MT = MP + MS;
constexpr int DFF = 2816, DIN = 3584, MMEM = 8 * 256, NKV = 40;
constexpr size_t OFF_Y = 0, OFF_POOLP = (size_t)MT * DM, OFF_POOLS = OFF_POOLP + 8 * 15 * 512, OFF_SGUV = OFF_POOLS + 32 * 15 * 512,
                 OFF_MK = OFF_SGUV + 32 * 16 * 512, OFF_MV = OFF_MK + (size_t)MMEM * DM, OUT_TOTAL = OFF_MV + (size_t)MMEM * DM;
constexpr int NWAVES = 8;
#ifndef MK_PER_PHASE
#define MK_PER_PHASE 0
#endif
constexpr int N_PHASES = 15;

constexpr size_t al256(size_t x) { return (x + 255) & ~(size_t)255; }
constexpr size_t WS_CTL = 0, CTL_ZERO_BYTES = 1u << 20;
constexpr size_t WS_W13A = CTL_ZERO_BYTES;
constexpr size_t WS_W2A  = WS_W13A + al256((size_t)2 * DFF * DM * 2);
constexpr size_t WS_WIN  = WS_W2A  + al256((size_t)DM * DFF * 2);
constexpr size_t WS_WA   = WS_WIN  + al256((size_t)DIN * DM * 2);
constexpr size_t WS_WPB  = WS_WA   + al256((size_t)DM * 512 * 2);
constexpr size_t WS_WO   = WS_WPB  + al256((size_t)DM * 512 * 2);
constexpr size_t WS_WMKV = WS_WO   + al256((size_t)DM * DM * 2);
constexpr size_t WS_WQ   = WS_WMKV + al256((size_t)2 * DM * DM * 2);
constexpr size_t WS_WCO  = WS_WQ   + al256((size_t)DM * DM * 2);
constexpr size_t WS_W13B = WS_WCO  + al256((size_t)DM * DM * 2);
constexpr size_t WS_W2B  = WS_W13B + al256((size_t)2 * DFF * DM * 2);
constexpr size_t WS_WSP  = WS_W2B  + al256((size_t)DM * DFF * 2);
constexpr size_t WS_WSS  = WS_WSP  + al256((size_t)4 * 128 * 128 * 2);
constexpr size_t WS_HB   = WS_WSS  + al256((size_t)4 * 128 * 128 * 2);
constexpr size_t WS_MEMN = WS_HB   + al256((size_t)MT * DM * 2);
constexpr size_t WS_KB   = WS_MEMN + al256((size_t)MMEM * DM * 2);
constexpr size_t WS_VT   = WS_KB   + al256((size_t)NKV * 256 * DM * 2);
constexpr size_t WS_ST0  = WS_VT   + al256((size_t)NKV * 256 * DM * 2);
constexpr size_t WS_ST1  = WS_ST0  + al256((size_t)MT * 64);
constexpr size_t WS_ST2  = WS_ST1  + al256((size_t)MT * 64);
constexpr size_t WS_ST3  = WS_ST2  + al256((size_t)MT * 64);
constexpr size_t WS_STV  = WS_ST3  + al256((size_t)MT * 64);
constexpr size_t WS_RACT = WS_STV  + al256((size_t)MT * 64);
constexpr size_t WS_GATE = WS_RACT, WS_DD = WS_GATE + (size_t)MT * 2048 * 2;
constexpr size_t WS_RZ   = WS_RACT + al256((size_t)MT * DFF * 2);
constexpr size_t WS_XA = WS_RZ, WS_UU = WS_XA + (size_t)MT * 512 * 2, WS_VV = WS_UU + (size_t)MT * 512 * 2, WS_US = WS_VV + (size_t)MT * 512 * 2;
constexpr size_t WS_MRG = WS_RZ, WS_QB = WS_RZ, WS_OB = WS_RZ + (size_t)MT * DM * 2;
constexpr size_t WS_END = WS_RZ + al256((size_t)MT * 2048 * 2);
static_assert(WS_DD + (size_t)MT * 512 * 2 <= WS_RZ, "gate | dd fit in the act region");
static_assert(WS_END <= (size_t)512 * 1024 * 1024, "d_ws map fits 512 MiB");
constexpr int CW_BAR = 4096, CW_XCC = 8192, CW_Q1 = 12288, CW_Q2 = 12352, CW_QF = 12416  , CW_DEP = 16384;
static_assert((CW_DEP + 8 * 136 * 64) * 4 <= (int)CTL_ZERO_BYTES, "CTL words inside the memset region");

constexpr int RING_BYTES = 131072, LDS_BYTES = 163840, LDSCTL_OFF = LDS_BYTES - 1024, MISC_OFF = LDSCTL_OFF + 320;

__device__ __forceinline__ float wave_sum(float v) {
#pragma unroll
    for (int o = 1; o < 64; o <<= 1) v += __shfl_xor(v, o);
    return v;
}
template <bool BLK = true>
__device__ __forceinline__ void transpose_item(const float* W, int ldn, int k0, int n0, const float* gain, bf16* WT, int ldk, int drow0, LAS float* scr, int lane) {
    f32x4 tv[16];
    const int r = lane >> 4, c4 = (lane & 15) * 4;
#pragma unroll
    for (int i = 0; i < 16; ++i) tv[i] = __builtin_nontemporal_load((const f32x4*)(W + (size_t)(k0 + 4 * i + r) * ldn + n0 + c4));
    if (gain) {
#pragma unroll
        for (int i = 0; i < 16; ++i) tv[i] = tv[i] * gain[k0 + 4 * i + r]; }
#pragma unroll
    for (int i = 0; i < 16; ++i) { LAS float* d = scr + (4 * i + r) * 65 + c4; d[0] = tv[i].x; d[1] = tv[i].y; d[2] = tv[i].z; d[3] = tv[i].w; }
    LDS_WAIT(); asm volatile("" ::: "memory");
#pragma unroll
    for (int j = 0; j < 8; ++j) {
        const int n = BLK ? 32 * (j >> 2) + pg8::perm32(16 * ((j >> 1) & 1) + (lane >> 2)) : (lane >> 3) + 8 * j;
        const int kc = BLK ? 32 * (j & 1) + 8 * (lane & 3) : 8 * (lane & 7);
        const LAS float* sp = scr + kc * 65 + n;
        v4u o; o.x = pk2(sp[0 * 65], sp[1 * 65]); o.y = pk2(sp[2 * 65], sp[3 * 65]); o.z = pk2(sp[4 * 65], sp[5 * 65]); o.w = pk2(sp[6 * 65], sp[7 * 65]);
        const int drow = drow0 + n;
        bf16* dp = BLK ? (bf16*)((unsigned char*)WT + (size_t)((drow >> 8) * (ldk >> 6) + (k0 >> 6)) * 32768 + pg8::img_off_w(drow & 255, kc)) : WT + (size_t)drow * ldk + k0 + kc;
        *(v4u*)dp = o; }
    LDS_WAIT(); asm volatile("" ::: "memory");
}
constexpr int TR_SCR_BYTES = 64 * 65 * 4;

struct Args { const float* in[32]; float* out; unsigned char* ws; int ph_lo, ph_hi; };

template <int PART>
__device__ __forceinline__ void phase_prep(const Args& A, LAS unsigned char* lds, int tid, int wave, int lane, int wgi, int nwg, unsigned* queue) {
    unsigned char* ws = A.ws;
    LAS float* scr = (LAS float*)(lds + wave * TR_SCR_BYTES);
    const int gw = wgi * NWAVES + wave, NGW = nwg * NWAVES;
    for (int pass = 0; pass < (PART == 0 ? 2 : 1); ++pass) {
    const bool do_ab = (PART != 0) || ((pass == 0) == ((wave & 1) == 0));
    if (do_ab) {
    constexpr int I_W1 = (DM / 64) * (DFF / 64), I_W2 = (DFF / 64) * (DM / 64), I_PB = (512 / 64) * (DM / 64), I_SQ = (DM / 64) * (DM / 64), I_VT = 32 * (256 / 64) * (DM / 64);
    constexpr int I_WINA = (DM / 64) * 24, I_WINB = (DM / 64) * 32;
    constexpr int VT1 = 23 * 64, VT2 = I_VT - VT1, I_PVT = 8 * 64;
    constexpr int NITEMS = PART == 0 ? 2 * I_W1 + I_W2 + I_WINA + 2 * I_SQ : (PART == 1 ? I_PB + 2 * I_SQ + I_WINB + VT1 : VT2 + I_PVT + 2 * I_W1 + I_W2 + I_SQ);
    constexpr int ROW0 = PART == 0 ? 0 : MT + MMEM, NROWS = PART == 0 ? MT + MMEM : (PART == 1 ? MT + MMEM : MT + MMEM + 32 * 256);
    constexpr int NWORK = NITEMS + (NROWS - ROW0) / 4;
    static_assert(MP % 4 == 0 && MT % 4 == 0 && MMEM % 4 == 0, "row items must not straddle kinds");
    const bool dyn = queue != nullptr;
    volatile LAS unsigned* qslot = (volatile LAS unsigned*)(lds + MISC_OFF) + 16;
    unsigned nextq = 0; if (dyn && tid == 0) nextq = __hip_atomic_fetch_add(queue, (unsigned)NWAVES, RLX_AGENT);
    int w = gw;
    for (;;) {
        if (dyn) { if (tid == 0) *qslot = nextq; __syncthreads(); const int base = (int)*qslot; __syncthreads(); if (base >= NWORK) break;
            if (tid == 0) nextq = __hip_atomic_fetch_add(queue, (unsigned)NWAVES, RLX_AGENT); w = base + wave; }
        if (w >= NWORK) { if (dyn) continue; else break; }
        if (w < NITEMS) {
        int r = w;
        do {
#define W13_ITEM(SRC, GAIN, DST, HALFSEL) if (r < I_W1) { const int nblk = DFF / 64, kb = r / nblk, nb = r % nblk, n0 = 64 * nb; \
            transpose_item(SRC, DFF, 64 * kb, n0, GAIN, (bf16*)(ws + DST), DM, (n0 >> 7) * 256 + HALFSEL * 128 + (n0 & 127), scr, lane); break; } r -= I_W1;
#define PLAIN_ITEM(SRC, KK, NN, GAIN, DST, ROWOFF, CNT) if (r < CNT) { const int nblk = NN / 64, kb = r / nblk, nb = r % nblk; \
            transpose_item(SRC, NN, 64 * kb, 64 * nb, GAIN, (bf16*)(ws + DST), KK, ROWOFF + 64 * nb, scr, lane); break; } r -= CNT;
#define VT_ITEM(FIRST, CNT) if (r < CNT) { const int q = r + FIRST, b = q / 64, rr = q % 64, kb = rr / 16, nb = rr % 16; \
            transpose_item<false>(A.in[4] + (size_t)b * 256 * DM, DM, 64 * kb, 64 * nb, nullptr, (bf16*)(ws + WS_VT) + (size_t)(8 + b) * DM * 256, 256, 64 * nb, scr, lane); break; } r -= CNT;
#define WIN_ITEM(NB0, NBC, CNT) if (r < CNT) { const int kb = r / NBC, nb = NB0 + r % NBC; \
            transpose_item(A.in[11], DIN, 64 * kb, 64 * nb, A.in[10], (bf16*)(ws + WS_WIN), DM, 64 * nb, scr, lane); break; } r -= CNT;
#define PVT_ITEM() if (r < I_PVT) { const int b = r / 64, rr = r % 64, kb = rr / 16, nb = rr % 16; \
            transpose_item<false>(A.out + OFF_MV + (size_t)b * 256 * DM, DM, 64 * kb, 64 * nb, nullptr, (bf16*)(ws + WS_VT) + (size_t)b * DM * 256, 256, 64 * nb, scr, lane); break; } r -= I_PVT;
        if constexpr (PART == 0) {
            W13_ITEM(A.in[7], A.in[6], WS_W13A, 0)
            W13_ITEM(A.in[8], A.in[6], WS_W13A, 1)
            PLAIN_ITEM(A.in[9], DFF, DM, nullptr, WS_W2A, 0, I_W2)
            WIN_ITEM(0, 24, I_WINA)
            PLAIN_ITEM(A.in[22], DM, DM, nullptr, WS_WMKV, 0, I_SQ)
            PLAIN_ITEM(A.in[23], DM, DM, nullptr, WS_WMKV, 1024, I_SQ)
        } else if constexpr (PART == 1) {
            PLAIN_ITEM(A.in[19], 512, DM, nullptr, WS_WPB, 0, I_PB)
            PLAIN_ITEM(A.in[20], DM, DM, nullptr, WS_WO, 0, I_SQ)
            PLAIN_ITEM(A.in[25], DM, DM, A.in[24], WS_WQ, 0, I_SQ)
            WIN_ITEM(24, 32, I_WINB)
            VT_ITEM(0, VT1)
        } else {
            VT_ITEM(VT1, VT2)
            PVT_ITEM()
            W13_ITEM(A.in[28], A.in[27], WS_W13B, 0)
            W13_ITEM(A.in[29], A.in[27], WS_W13B, 1)
            PLAIN_ITEM(A.in[30], DFF, DM, nullptr, WS_W2B, 0, I_W2)
            PLAIN_ITEM(A.in[26], DM, DM, nullptr, WS_WCO, 0, I_SQ)
        }
#undef W13_ITEM
#undef PLAIN_ITEM
#undef VT_ITEM
#undef WIN_ITEM
#undef PVT_ITEM
        } while (false);
        } else if constexpr (PART != 1) {
            const int r0 = ROW0 + 4 * (w - NITEMS);
            int kind; const float* src; bf16* dst;
            if (r0 < MT) { kind = 0; src = (r0 < MP) ? A.in[0] + (size_t)r0 * DM : A.in[1] + (size_t)(r0 - MP) * DM; dst = (bf16*)(ws + WS_HB) + (size_t)r0 * DM; }
            else if (r0 < MT + MMEM) { kind = 1; src = A.in[5] + (size_t)(r0 - MT) * DM; dst = (bf16*)(ws + WS_MEMN) + (size_t)(r0 - MT) * DM; }
            else { kind = 2; src = A.in[3] + (size_t)(r0 - MT - MMEM) * DM; dst = (bf16*)(ws + WS_KB) + (size_t)(8 * 256 + (r0 - MT - MMEM)) * DM; }
            f32x4 v[4][4];
#pragma unroll
            for (int h = 0; h < 4; ++h)
#pragma unroll
                for (int j = 0; j < 4; ++j) v[h][j] = __builtin_nontemporal_load((const f32x4*)(src + (size_t)h * DM) + lane + 64 * j);
#pragma unroll
            for (int h = 0; h < 4; ++h) { const int rr = r0 + h;
                float s = 0.f;
#pragma unroll
                for (int j = 0; j < 4; ++j) s += (v[h][j].x * v[h][j].x + v[h][j].y * v[h][j].y) + (v[h][j].z * v[h][j].z + v[h][j].w * v[h][j].w);
                if (kind != 2) s = wave_sum(s);
                if (kind == 0) { float* st = (float*)(ws + WS_ST0) + (size_t)rr * 16; if (lane < 16) st[lane] = (lane == 0) ? s : 0.f; }
                if (kind == 1) { const float rin = 1.0f / sqrtf(s * (1.0f / DM) + 1e-6f); const f32x4* gr = (const f32x4*)A.in[21] + lane;
#pragma unroll
                    for (int j = 0; j < 4; ++j) v[h][j] = v[h][j] * rin * gr[64 * j]; }
                unsigned long long* o8 = (unsigned long long*)(dst + (size_t)h * DM) + lane;
#pragma unroll
                for (int j = 0; j < 4; ++j) { const unsigned long long ov = (unsigned long long)pk2(v[h][j].x, v[h][j].y) | ((unsigned long long)pk2(v[h][j].z, v[h][j].w) << 32);
                    if (kind == 0) *(unsigned long long*)(ws + WS_HB + pg8::hb_byte(rr, 4 * (lane + 64 * j))) = ov;
                    else if (kind == 1) *(unsigned long long*)(ws + WS_MEMN + pg8::hb_byte(rr - MT, 4 * (lane + 64 * j))) = ov; else o8[64 * j] = ov; } }
        }
        if (!dyn) w += NGW;
    }
    } else {
    if constexpr (PART == 0) {
    const int gt = wgi * (NWAVES * 64) + tid, NGT = nwg * NWAVES * 64;
    for (int idx = gt; idx < 512 * 256; idx += NGT) {
        const int k = idx >> 8, n4 = (idx & 255) * 4, g = k >> 7;
        const float* wp = A.in[13] + (size_t)k * 128; const float* ps = A.in[14] + g * 128; const float* pa = A.in[18] + (size_t)(g * 128) * DM + n4;
        f32x4 acc = (f32x4){0.f, 0.f, 0.f, 0.f};
#pragma unroll 16
        for (int d = 0; d < 128; ++d) { const float c = wp[d] * ps[d]; acc += *(const f32x4*)(pa + (size_t)d * DM) * c; }
        unsigned char* ob = ws + WS_WA + (size_t)((n4 >> 8) * 8 + (k >> 6)) * 32768;
        *(bf16*)(ob + pg8::img_off_w((n4 & 255) + 0, k & 63)) = (bf16)f2bf(acc.x); *(bf16*)(ob + pg8::img_off_w((n4 & 255) + 1, k & 63)) = (bf16)f2bf(acc.y);
        *(bf16*)(ob + pg8::img_off_w((n4 & 255) + 2, k & 63)) = (bf16)f2bf(acc.z); *(bf16*)(ob + pg8::img_off_w((n4 & 255) + 3, k & 63)) = (bf16)f2bf(acc.w);
    }
    for (int idx = gt; idx < 2 * 65536; idx += NGT) {
        const int smp = idx >> 16, h = (idx >> 14) & 3, p = (idx >> 7) & 127, q = idx & 127;
        float w;
        if (!smp) w = ((p >> 6) >= (q >> 6)) ? A.in[16][(size_t)(h * 128 + p) * 128 + q] : 0.f;
        else w = ((p >> 4) == (q >> 4)) ? A.in[16][(size_t)(h * 128 + (p & 15)) * 128 + (q & 15)] : 0.f;
        ((bf16*)(ws + (smp ? WS_WSS : WS_WSP)))[(size_t)(h * 128 + p) * 128 + q] = (bf16)f2bf(w);
    }
    }
    }
    }
}

__device__ __forceinline__ void phase_mixprep(const Args& A, LAS unsigned char* lds, int tid, int wave, int lane, int vcu, int G) {
    unsigned char* ws = A.ws;
    const int gw = vcu * NWAVES + wave, NGW = G * NWAVES;
    {
        const bf16* xa = (const bf16*)(ws + WS_XA); bf16* dd = (bf16*)(ws + WS_DD);
        const int cg = lane, w = 2 << (cg >> 4);
        const int pgw = (G == 256) ? (vcu >= 16 ? (vcu - 16) * NWAVES + wave : MT) : gw, pngw = (G == 256) ? 240 * NWAVES : NGW;
        for (int rr = pgw; rr < MT / 16; rr += pngw) {
            const int row0 = rr * 16; const bool smp = row0 >= MP;
            const int t0 = smp ? 0 : (row0 & 4095);
            const bf16* xp = xa + (size_t)row0 * 512 + cg * 8;
            v4u X[31];
#pragma unroll
            for (int i = 0; i < 16; ++i) X[15 + i] = *(const v4u*)(xp + i * 512);
            if (smp) {
                const float* stp = A.in[2] + (size_t)((row0 - MP) >> 4) * 15 * 512 + cg * 8;
#pragma unroll
                for (int j = 1; j < 16; ++j) { const f32x4 a = *(const f32x4*)(stp + (15 - j) * 512), b = *(const f32x4*)(stp + (15 - j) * 512 + 4);
                    v4u p; p.x = pk2(a.x, a.y); p.y = pk2(a.z, a.w); p.z = pk2(b.x, b.y); p.w = pk2(b.z, b.w); X[15 - j] = p; }
            } else {
#pragma unroll
                for (int j = 1; j < 16; ++j) { const bool ok = t0 - j >= 0; const v4u x = *(const v4u*)(xp - (ok ? j : 0) * 512); X[15 - j] = ok ? x : (v4u){0u, 0u, 0u, 0u}; }
            }
            float s[8];
#pragma unroll
            for (int j = 0; j < 8; ++j) s[j] = 0.f;
#pragma unroll
            for (int j = 1; j < 16; ++j) { const float mk = (j < w) ? 1.0f : 0.0f; const v4u x = X[15 - j];
                s[0] += mk * bf_lo(x.x); s[1] += mk * bf_hi(x.x); s[2] += mk * bf_lo(x.y); s[3] += mk * bf_hi(x.y); s[4] += mk * bf_lo(x.z); s[5] += mk * bf_hi(x.z); s[6] += mk * bf_lo(x.w); s[7] += mk * bf_hi(x.w); }
#pragma unroll
            for (int i = 0; i < 16; ++i) {
                const v4u x = X[15 + i];
                s[0] += bf_lo(x.x); s[1] += bf_hi(x.x); s[2] += bf_lo(x.y); s[3] += bf_hi(x.y); s[4] += bf_lo(x.z); s[5] += bf_hi(x.z); s[6] += bf_lo(x.w); s[7] += bf_hi(x.w);
                const int nv = smp ? w : ((t0 + i + 1 < w) ? t0 + i + 1 : w);
                const float ic = 1.0f / (float)nv;
                v4u o; o.x = pk2(s[0] * ic - bf_lo(x.x), s[1] * ic - bf_hi(x.x)); o.y = pk2(s[2] * ic - bf_lo(x.y), s[3] * ic - bf_hi(x.y)); o.z = pk2(s[4] * ic - bf_lo(x.z), s[5] * ic - bf_hi(x.z)); o.w = pk2(s[6] * ic - bf_lo(x.w), s[7] * ic - bf_hi(x.w));
                *(v4u*)((unsigned char*)dd + pg8::k512_byte(row0 + i, cg * 8)) = o;
                const v4u y2 = X[14 + i], y4 = X[12 + i], y8 = X[8 + i], y16 = X[i];
                v4u y; y.x = (w == 2) ? y2.x : (w == 4) ? y4.x : (w == 8) ? y8.x : y16.x; y.y = (w == 2) ? y2.y : (w == 4) ? y4.y : (w == 8) ? y8.y : y16.y;
                y.z = (w == 2) ? y2.z : (w == 4) ? y4.z : (w == 8) ? y8.z : y16.z; y.w = (w == 2) ? y2.w : (w == 4) ? y4.w : (w == 8) ? y8.w : y16.w;
                s[0] -= bf_lo(y.x); s[1] -= bf_hi(y.x); s[2] -= bf_lo(y.y); s[3] -= bf_hi(y.y); s[4] -= bf_lo(y.z); s[5] -= bf_hi(y.z); s[6] -= bf_lo(y.w); s[7] -= bf_hi(y.w);
            }
        }
    }
    __syncthreads();
    {
        const bf16* vv = (const bf16*)(ws + WS_VV); const bf16* uu = (const bf16*)(ws + WS_UU); bf16* us = (bf16*)(ws + WS_US);
        const float* stv = (const float*)(ws + WS_STV);
        LAS bf16* VT = (LAS bf16*)lds;
        const int fr = lane & 15, fq = lane >> 4;
        for (int un = vcu; un < (MT / 128) * 4; un += G) {
            const int ci = un >> 2, hd = un & 3, row0 = ci * 128; const bool smp = row0 >= MP;
            const bf16* wsel = (const bf16*)(ws + (smp ? WS_WSS : WS_WSP)) + (size_t)hd * 128 * 128;
            const int p = wave * 16 + fr, prow = row0 + p;
            bf16x8 wf[4];
#pragma unroll
            for (int ks = 0; ks < 4; ++ks) wf[ks] = *(const bf16x8*)(wsel + (size_t)p * 128 + ks * 32 + 8 * fq);
            unsigned long long ur[8];
#pragma unroll
            for (int nt = 0; nt < 8; ++nt) ur[nt] = __builtin_nontemporal_load((const unsigned long long*)(uu + (size_t)prow * 512 + hd * 128 + nt * 16 + 4 * fq));
            const f32x4 g0 = *(const f32x4*)(A.in[15] + hd * 128 + (tid & 15) * 8), g1 = *(const f32x4*)(A.in[15] + hd * 128 + (tid & 15) * 8 + 4);
#pragma unroll
            for (int it = 0; it < 4; ++it) {
                const int idx = it * 512 + tid, q = idx >> 4, c8 = idx & 15, row = row0 + q;
                const v4u raw = __builtin_nontemporal_load((const v4u*)(vv + (size_t)row * 512 + hd * 128 + c8 * 8));
                const f32x4* sp = (const f32x4*)(stv + (size_t)row * 16); const f32x4 a = sp[0], b = sp[1], c = sp[2], d = sp[3];
                const float sum = ((a.x + a.z) + (b.x + b.z)) + ((c.x + c.z) + (d.x + d.z)), sq = ((a.y + a.w) + (b.y + b.w)) + ((c.y + c.w) + (d.y + d.w));
                const float mu = sum * (1.0f / 512.0f); float var = sq * (1.0f / 512.0f) - mu * mu; var = var > 0.f ? var : 0.f;
                const float rs = 1.0f / sqrtf(var + 1e-6f);
                float x[8];
                x[0] = (bf_lo(raw.x) - mu) * rs * g0.x; x[1] = (bf_hi(raw.x) - mu) * rs * g0.y; x[2] = (bf_lo(raw.y) - mu) * rs * g0.z; x[3] = (bf_hi(raw.y) - mu) * rs * g0.w;
                x[4] = (bf_lo(raw.z) - mu) * rs * g1.x; x[5] = (bf_hi(raw.z) - mu) * rs * g1.y; x[6] = (bf_lo(raw.w) - mu) * rs * g1.z; x[7] = (bf_hi(raw.w) - mu) * rs * g1.w;
                if (smp) { float* dst = A.out + OFF_SGUV + (size_t)(row - MP) * 512 + hd * 128 + c8 * 8; *(f32x4*)dst = (f32x4){x[0], x[1], x[2], x[3]}; *(f32x4*)(dst + 4) = (f32x4){x[4], x[5], x[6], x[7]}; }
#pragma unroll
                for (int j = 0; j < 8; ++j) VT[(c8 * 8 + j) * 136 + ((((q >> 3) ^ c8) << 3) | (q & 7))] = (bf16)f2bf(x[j]);
            }
            __syncthreads();
            f32x4 acc[8];
#pragma unroll
            for (int nt = 0; nt < 8; ++nt) acc[nt] = (f32x4){0.f, 0.f, 0.f, 0.f};
#pragma unroll
            for (int ks = 0; ks < 4; ++ks) {
#pragma unroll
                for (int nt = 0; nt < 8; ++nt) { const bf16x8 vf = *(const LAS bf16x8*)(VT + (nt * 16 + fr) * 136 + (((ks * 4 + fq) ^ (nt * 2 + (fr >> 3))) << 3));
                    acc[nt] = __builtin_amdgcn_mfma_f32_16x16x32_bf16(vf, wf[ks], acc[nt], 0, 0, 0); }
            }
            const float bias = A.in[17][hd * 128 + (smp ? fr : p)];
#pragma unroll
            for (int nt = 0; nt < 8; ++nt) { const int col = hd * 128 + nt * 16 + 4 * fq;
                const unsigned u0 = (unsigned)ur[nt], u1 = (unsigned)(ur[nt] >> 32);
                const float o0 = bf_lo(u0) * (acc[nt].x + bias), o1 = bf_hi(u0) * (acc[nt].y + bias), o2 = bf_lo(u1) * (acc[nt].z + bias), o3 = bf_hi(u1) * (acc[nt].w + bias);
                *(unsigned long long*)((unsigned char*)us + pg8::k512_byte(prow, col)) = (unsigned long long)pk2(o0, o1) | ((unsigned long long)pk2(o2, o3) << 32); }
            __syncthreads();
        }
    }
}

__device__ __forceinline__ void glds16_asm(const void* gsrc, unsigned lds_dst) {
    unsigned keep;
    asm volatile("s_mov_b32 %0, m0\n\ts_mov_b32 m0, %2\n\ts_nop 0\n\tglobal_load_lds_dwordx4 %1, off\n\ts_mov_b32 m0, %0" : "=&s"(keep) : "v"(gsrc), "s"(lds_dst) : "memory");
}
constexpr int ATT_NBUF = 5, ATT_CHB = 16384, ATT_P_OFF = ATT_NBUF * ATT_CHB, ATT_P_STRIDE = 8448, ATT_ITEMS = 1024 + 128;
static_assert(ATT_P_OFF + 8 * ATT_P_STRIDE <= LDSCTL_OFF, "attention LDS map");
__device__ __forceinline__ void phase_attention(const Args& A, LAS unsigned char* lds, int tid, int wave, int lane, int vcu, int G) {
    unsigned char* ws = A.ws;
    const bf16* qb = (const bf16*)(ws + WS_QB); const bf16* kb = (const bf16*)(ws + WS_KB); const bf16* vt = (const bf16*)(ws + WS_VT); bf16* ob = (bf16*)(ws + WS_OB);
    LAS bf16* P = (LAS bf16*)(lds + ATT_P_OFF + wave * ATT_P_STRIDE);
    const int fr = lane & 15, fq = lane >> 4;
    int srow[2], scolK[2], scolV[2];
#pragma unroll
    for (int i = 0; i < 2; ++i) { const int p = (wave * 2 + i) * 64 + lane; srow[i] = p >> 5; scolV[i] = ((p & 31) ^ (srow[i] & 15)) * 8; scolK[i] = ((p & 31) ^ ((((srow[i] >> 3) & 3) << 2) | (srow[i] & 3))) * 8; }
    const unsigned lds_base = __builtin_amdgcn_readfirstlane((unsigned)(size_t)lds);
    const int rd_off = fr * 512 + ((fq ^ fr) * 16);
    const int rdk_off = (8 * (fr >> 2) + (fr & 3)) * 512 + ((fq ^ fr) * 16);
    for (int it0 = vcu; it0 < ATT_ITEMS; it0 += G) {
        int it = it0;
        if (G == 256 && it0 < 1024) { const int rnd = it0 >> 8, pair = (vcu >> 5) * 4 + ((vcu >> 3) & 3); it = pair * 32 + (vcu & 7) + 8 * rnd; }
        int kvb, hd, rbase, nact;
        if (it < 1024) { kvb = it >> 7; hd = (it >> 5) & 3; rbase = kvb * 4096 + (it & 31) * 128; nact = 8; }
        else { const int t = it - 1024; kvb = 8 + (t >> 2); hd = t & 3; rbase = MP + (t >> 2) * 16; nact = 1; }
        const bool active = wave < nact;
        const int r0 = rbase + (active ? wave : 0) * 16;
        const bf16* gp[2];
#pragma unroll
        for (int i = 0; i < 2; ++i) gp[i] = kb + (size_t)kvb * 256 * DM + hd * 256 + (size_t)srow[i] * DM + scolK[i];
        const bf16* vsrc = vt + ((size_t)kvb * DM + hd * 256) * 256;
#define ATT_ISSUE(c) do { const unsigned dstb = lds_base + ((c) % ATT_NBUF) * ATT_CHB + wave * 2048; \
            _Pragma("unroll") for (int i = 0; i < 2; ++i) { if ((c) == 8) gp[i] = vsrc + (size_t)srow[i] * 256 + scolV[i]; \
                glds16_asm(gp[i], dstb + i * 1024); \
                gp[i] += ((c) < 8) ? 32 * DM : 32 * 256; asm volatile("" : "+v"(gp[i])); } } while (0)
#define ATT_BOUNDARY(b) do { if ((b) <= 12) asm volatile("s_waitcnt vmcnt(6)" ::: "memory"); else if ((b) == 13) asm volatile("s_waitcnt vmcnt(4)" ::: "memory"); \
            else if ((b) == 14) asm volatile("s_waitcnt vmcnt(2)" ::: "memory"); else asm volatile("s_waitcnt vmcnt(0)" ::: "memory"); \
            asm volatile("s_waitcnt lgkmcnt(0)" ::: "memory"); __builtin_amdgcn_s_barrier(); asm volatile("" ::: "memory"); \
            if ((b) + 4 < 16) ATT_ISSUE((b) + 4); } while (0)
#define ATT_LOAD(dst, c, h) do { const LAS unsigned char* _b = lds + ((c) % ATT_NBUF) * ATT_CHB + (((c) < 8) ? (h) * 2048 + rdk_off : (h) * 8192 + rd_off); \
            _Pragma("unroll") for (int ks = 0; ks < 8; ++ks) dst[ks] = *(const LAS bf16x8*)(_b + ((((c) < 8) ? rdk_off : rd_off) ^ (ks * 64)) - (((c) < 8) ? rdk_off : rd_off)); } while (0)
        ATT_ISSUE(0); ATT_ISSUE(1); ATT_ISSUE(2); ATT_ISSUE(3);
        bf16x8 qf[8];
        {
#pragma unroll
            for (int ks = 0; ks < 8; ++ks) qf[ks] = __builtin_nontemporal_load((const bf16x8*)((const unsigned char*)qb + pg8::hb_byte(r0 + fr, hd * 256 + ks * 32 + 8 * fq)));
#pragma unroll
            for (int ks = 0; ks < 8; ++ks) asm volatile("" : "+v"(qf[ks])); }
        f32x4 s[16];
#pragma unroll
        for (int nt = 0; nt < 16; ++nt) s[nt] = (f32x4){0.f, 0.f, 0.f, 0.f};
        if (!active) {
            ATT_BOUNDARY(0);
#pragma unroll
            for (int c = 0; c < 15; ++c) ATT_BOUNDARY(c + 1);
        } else {
        bf16x8 fa[8], fb[8]; float inv = 0.f;
        ATT_BOUNDARY(0);
        ATT_LOAD(fa, 0, 0);
#pragma unroll
        for (int c = 0; c < 16; ++c) {
            ATT_LOAD(fb, c, 1);
            __builtin_amdgcn_sched_barrier(0);
            if (c < 8) {
#pragma unroll
                for (int ks = 0; ks < 8; ++ks) s[c * 2] = __builtin_amdgcn_mfma_f32_16x16x32_bf16(fa[ks], qf[ks], s[c * 2], 0, 0, 0);
            } else {
                f32x4 o = (f32x4){0.f, 0.f, 0.f, 0.f};
#pragma unroll
                for (int ks = 0; ks < 8; ++ks) o = __builtin_amdgcn_mfma_f32_16x16x32_bf16(fa[ks], qf[ks], o, 0, 0, 0);
                *(LAS unsigned long long*)(P + fr * 264 + (c - 8) * 32 + 4 * fq) = (unsigned long long)pk2(o.x * inv, o.y * inv) | ((unsigned long long)pk2(o.z * inv, o.w * inv) << 32);
            }
            __builtin_amdgcn_sched_barrier(0);
            if (c < 15) { ATT_BOUNDARY(c + 1); ATT_LOAD(fa, c + 1, 0); }
            __builtin_amdgcn_sched_barrier(0);
            if (c < 8) {
#pragma unroll
                for (int ks = 0; ks < 8; ++ks) s[c * 2 + 1] = __builtin_amdgcn_mfma_f32_16x16x32_bf16(fb[ks], qf[ks], s[c * 2 + 1], 0, 0, 0);
                if (c == 7) {
                    float mx = s[0][0];
#pragma unroll
                    for (int nt = 0; nt < 16; ++nt)
#pragma unroll
                        for (int j = 0; j < 4; ++j) mx = fmaxf(mx, s[nt][j]);
                    mx = fmaxf(mx, __shfl_xor(mx, 16)); mx = fmaxf(mx, __shfl_xor(mx, 32));
                    float sm = 0.f;
#pragma unroll
                    for (int ks = 0; ks < 8; ++ks) { float pe[8];
#pragma unroll
                        for (int h = 0; h < 2; ++h)
#pragma unroll
                            for (int j = 0; j < 4; ++j) { pe[4 * h + j] = __builtin_amdgcn_exp2f(s[2 * ks + h][j] - mx); sm += pe[4 * h + j]; }
                        pg8::u32x4 w; w.x = pg8::cvt_pk_bf16(pe[0], pe[1]); w.y = pg8::cvt_pk_bf16(pe[2], pe[3]); w.z = pg8::cvt_pk_bf16(pe[4], pe[5]); w.w = pg8::cvt_pk_bf16(pe[6], pe[7]);
                        qf[ks] = __builtin_bit_cast(bf16x8, w); }
                    sm += __shfl_xor(sm, 16); sm += __shfl_xor(sm, 32); inv = 1.0f / sm;
                }
            } else {
                f32x4 o = (f32x4){0.f, 0.f, 0.f, 0.f};
#pragma unroll
                for (int ks = 0; ks < 8; ++ks) o = __builtin_amdgcn_mfma_f32_16x16x32_bf16(fb[ks], qf[ks], o, 0, 0, 0);
                *(LAS unsigned long long*)(P + fr * 264 + (c - 8) * 32 + 16 + 4 * fq) = (unsigned long long)pk2(o.x * inv, o.y * inv) | ((unsigned long long)pk2(o.z * inv, o.w * inv) << 32);
            }
            __builtin_amdgcn_sched_barrier(0);
        }
        }
        if (active) { LDS_WAIT(); asm volatile("" ::: "memory"); __builtin_amdgcn_wave_barrier();
#pragma unroll
            for (int t = 0; t < 8; ++t) { const int row = lane >> 2, c4 = lane & 3;
                const v4u w = *(const LAS v4u*)(P + row * 264 + t * 32 + c4 * 8); *(v4u*)((unsigned char*)ob + pg8::hb_byte(r0 + row, hd * 256 + t * 32 + c4 * 8)) = w; } }
        asm volatile("s_waitcnt lgkmcnt(0)" ::: "memory"); __builtin_amdgcn_s_barrier(); asm volatile("" ::: "memory");
#undef ATT_ISSUE
#undef ATT_BOUNDARY
#undef ATT_LOAD
    }
    VM_WAIT(); __syncthreads();
}

__device__ __forceinline__ void wait_panel(const unsigned* dep, int pm, unsigned need, unsigned* tmo) {
    if (threadIdx.x < 64) {
        unsigned polls = 0;
        while ((unsigned)__builtin_amdgcn_readfirstlane(__hip_atomic_load(dep + 64 * pm, RLX_AGENT)) < need) {
            if ((++polls & 1023u) == 0u) { if (__builtin_amdgcn_readfirstlane(__hip_atomic_load(tmo, RLX_AGENT)) != 0u) break;
                if (polls > (1u << 22)) { if (threadIdx.x == 0) __hip_atomic_store(tmo, 1u, RLX_AGENT); break; } }
            __builtin_amdgcn_s_sleep(2); }
        __builtin_amdgcn_fence(__ATOMIC_ACQUIRE, "agent");
        asm volatile("s_waitcnt vmcnt(0)" ::: "memory");
    }
    asm volatile("" ::: "memory"); __builtin_amdgcn_s_barrier(); asm volatile("" ::: "memory");
}
__device__ __forceinline__ void phase_final_q(const Args& A, LAS unsigned char* lds, int tid, int wave, int lane, int bx, unsigned* queues, const unsigned* dep, unsigned* tmo) {
    const bf16* hb = (const bf16*)(A.ws + WS_HB); const float* st = (const float*)(A.ws + WS_ST0);
    f32x4 g0[2], g1[2];
#pragma unroll
    for (int j = 0; j < 2; ++j) { g0[j] = *(const f32x4*)(A.in[31] + 8 * (lane + 64 * j)); g1[j] = *(const f32x4*)(A.in[31] + 8 * (lane + 64 * j) + 4); }
    volatile LAS unsigned* qslot = (volatile LAS unsigned*)(lds + MISC_OFF) + 16;
    int okpm = -1;
    for (int pass = 0; pass < 2; ++pass) {
        unsigned* q = queues + 64 * (pass == 0 ? (bx & 7) : 8);
        const int nround = pass == 0 ? 16 * 8 : 2 * 8, pm0 = pass == 0 ? 16 * (bx & 7) : 128;
        unsigned nextq = 0; if (tid == 0) nextq = __hip_atomic_fetch_add(q, 1u, RLX_AGENT);
        for (;;) {
            if (tid == 0) *qslot = nextq; __syncthreads(); const int rd = (int)*qslot; __syncthreads(); if (rd >= nround) break;
            if (tid == 0) nextq = __hip_atomic_fetch_add(q, 1u, RLX_AGENT);
            const int pm = pm0 + (rd >> 3);
            if (pm != okpm) { wait_panel(dep, pm, 32u, tmo); okpm = pm; }
            const int row0 = pm * 256 + (rd & 7) * 32 + wave * 4;
            v4u h[4][2]; f32x4 pq[4];
#pragma unroll
            for (int k = 0; k < 4; ++k) { const int r = row0 + k;
                pq[k] = *(const f32x4*)(st + (size_t)r * 16 + 4 * (lane & 3));
#pragma unroll
                for (int j = 0; j < 2; ++j) h[k][j] = __builtin_nontemporal_load((const v4u*)((const unsigned char*)hb + pg8::hb_byte(r, 8 * (lane + 64 * j)))); }
#pragma unroll
            for (int k = 0; k < 4; ++k) { const int row = row0 + k;
                float sq = (pq[k].x + pq[k].y) + (pq[k].z + pq[k].w); sq += __shfl_xor(sq, 1); sq += __shfl_xor(sq, 2);
                const float rin = __builtin_amdgcn_rsqf(sq * (1.0f / DM) + 1e-6f);
                float* yr = A.out + OFF_Y + (size_t)row * DM;
#pragma unroll
                for (int j = 0; j < 2; ++j) { const int c = 8 * (lane + 64 * j); const v4u hh = h[k][j];
                    f32x4 a, b; a.x = bf_lo(hh.x); a.y = bf_hi(hh.x); a.z = bf_lo(hh.y); a.w = bf_hi(hh.y); b.x = bf_lo(hh.z); b.y = bf_hi(hh.z); b.z = bf_lo(hh.w); b.w = bf_hi(hh.w);
                    __builtin_nontemporal_store(a * rin * g0[j], (f32x4*)(yr + c)); __builtin_nontemporal_store(b * rin * g1[j], (f32x4*)(yr + c + 4)); } }
        }
    }
}

__global__ void __launch_bounds__(NWAVES * 64, 2) fwd_kernel(Args args) {
    extern __shared__ __attribute__((aligned(16))) unsigned char lds_raw[];
    LAS unsigned char* lds = (LAS unsigned char*)lds_raw;
    volatile LAS unsigned* MISC = (volatile LAS unsigned*)(lds + MISC_OFF);
    const int tid = threadIdx.x, lane = tid & 63, wave = __builtin_amdgcn_readfirstlane(tid >> 6);
    const int G = gridDim.x; const int bx = blockIdx.x; const int vcu = (G % 8 == 0) ? (bx % 8) * (G / 8) + bx / 8 : bx;
    unsigned char* ws = args.ws;
    gu32* ctl = (gu32*)(ws + WS_CTL);
    for (int u = tid; u < (LDS_BYTES - LDSCTL_OFF) / 4; u += NWAVES * 64) ((LAS unsigned*)(lds + LDSCTL_OFF))[u] = 0u;
    __syncthreads();
    XcdBarrier bar; bar.bar = (unsigned*)(ctl + CW_BAR); bar.x = 0; bar.st = nullptr;
    if (!MK_PER_PHASE) bar = xcd_barrier_post((unsigned*)(ctl + CW_BAR), MISC + 8);
    const int lo = args.ph_lo, hi = args.ph_hi;
#ifndef PH_MASK
#define PH_MASK 0x7fff
#endif
#define IN(k) (((PH_MASK >> (k)) & 1) && lo <= (k) && (k) < hi)
#define SEAM(k) do { if (IN(k) && IN((k) + 1)) xcd_barrier(bar); } while (0)
#ifndef DF_BARRIERS
#define DF_BARRIERS 0
#endif
#define DSEAM(k) do { if (DF_BARRIERS) SEAM(k); } while (0)
    using pg8::Gemm; using pg8::StaticOrder; using pg8::DepOrder; using pg8::EpiKV; using pg8::EpiSwiglu; using pg8::EpiRes; using pg8::EpiZ; using pg8::EpiGate; using pg8::EpiQ; using pg8::gemm_phase; using pg8::bf16_t;
    float* const out = args.out;
    bf16_t* const HB = (bf16_t*)(ws + WS_HB);
    float* const ST0 = (float*)(ws + WS_ST0); float* const ST1 = (float*)(ws + WS_ST1); float* const ST2 = (float*)(ws + WS_ST2); float* const ST3 = (float*)(ws + WS_ST3);

    unsigned* const xtab = (unsigned*)(ctl + CW_XCC);
    if (tid == 0) __hip_atomic_store(xtab + bx, 0x100u | xb_xcc_id(), RLX_AGENT);
    if (IN(0)) { phase_prep<0>(args, lds, tid, wave, lane, vcu, G, nullptr); }
    SEAM(0);
    bool wtall = true;
    if (!MK_PER_PHASE && G == 256 && IN(0) && IN(1)) {
        const unsigned mine = 0x100u | xb_xcc_id();
        const unsigned other = (lane < 32) ? __hip_atomic_load(xtab + (bx & 7) + 8 * lane, RLX_AGENT) : mine;
        wtall = !__all(other == mine);
    }
    unsigned* const dctr = (unsigned*)(ctl + CW_DEP); unsigned* const tmo = (unsigned*)(ctl + 0);
#define DEPC(k) (dctr + (size_t)(k) * 136 * 64)
#define ROT(r) ((bx + G - (r)) % G)
    if (IN(2)) {
        Gemm g{HB, (const bf16_t*)(ws + WS_W13A), MT, 2 * DFF, DM, true}; DepOrder S; S.init(MT, 2 * DFF, G, ROT(0)); S.dep = nullptr; S.need = 0; S.sig = DEPC(0); S.tmo = tmo; S.skew = 1;
        EpiSwiglu E{(bf16_t*)(ws + WS_RACT), ST0, wtall};
        gemm_phase<EpiSwiglu, DepOrder, true, true>(lds, g, S, E);
    }
    DSEAM(2);
    if (IN(3)) {
        Gemm g{(const bf16_t*)(ws + WS_RACT), (const bf16_t*)(ws + WS_W2A), MT, DM, DFF, true}; DepOrder S; S.init(MT, DM, G, ROT(48)); S.dep = DEPC(0); S.need = 22 * 8; S.sig = DEPC(1); S.tmo = tmo;
        EpiRes<false> E{HB, ST1, nullptr, 0.5f, wtall};
        gemm_phase<EpiRes<false>, DepOrder, true, true>(lds, g, S, E);
        Gemm g1{(const bf16_t*)(ws + WS_MEMN), (const bf16_t*)(ws + WS_WMKV), MMEM, 2 * DM, DM, true}; StaticOrder S1; S1.init(MMEM, 2 * DM, G, (G == 256) ? ((bx >= 56 && bx < 120) ? bx - 56 : (1 << 20)) : bx);
        EpiKV E1{out + OFF_MK, out + OFF_MV, (bf16_t*)(ws + WS_KB)};
        gemm_phase<EpiKV, StaticOrder, true, true>(lds, g1, S1, E1);
    }
    DSEAM(3);
    if (IN(4)) {
        Gemm g{HB, (const bf16_t*)(ws + WS_WIN), MT, 6 * 256, DM, true}; DepOrder S; S.init(MT, 6 * 256, G, ROT(120)); S.dep = DEPC(1); S.need = 4 * 8; S.sig = nullptr; S.tmo = tmo;
        EpiZ E{ST1, (bf16_t*)(ws + WS_XA), (bf16_t*)(ws + WS_UU), (bf16_t*)(ws + WS_VV), (bf16_t*)(ws + WS_GATE), (float*)(ws + WS_STV), args.in[12], out + OFF_POOLP, out + OFF_POOLS, 0, wtall};
        gemm_phase<EpiZ, DepOrder, true, true>(lds, g, S, E);
    }
    if (IN(4)) phase_prep<1>(args, lds, tid, wave, lane, 0, 1, (unsigned*)(ctl + CW_Q1));
    SEAM(4);
    if (IN(5)) { phase_mixprep(args, lds, tid, wave, lane, vcu, G); }
    SEAM(5);
    if (IN(6)) {
        Gemm g{HB, (const bf16_t*)(ws + WS_WIN) + (size_t)6 * 256 * DM, MT, 8 * 256, DM, true}; DepOrder S; S.init(MT, 8 * 256, G, ROT(0)); S.dep = nullptr; S.need = 0; S.sig = DEPC(2); S.tmo = tmo;
        EpiZ E{ST1, (bf16_t*)(ws + WS_XA), (bf16_t*)(ws + WS_UU), (bf16_t*)(ws + WS_VV), (bf16_t*)(ws + WS_GATE), (float*)(ws + WS_STV), args.in[12], out + OFF_POOLP, out + OFF_POOLS, 6, wtall};
        gemm_phase<EpiZ, DepOrder, true, true>(lds, g, S, E);
    }
    DSEAM(6);
    if (IN(7)) {
        { Gemm g{(const bf16_t*)(ws + WS_DD), (const bf16_t*)(ws + WS_WA), MT, DM, 512, true}; DepOrder S; S.init(MT, DM, G, ROT(16)); S.dep = DEPC(2); S.need = 8 * 8; S.sig = nullptr; S.tmo = tmo;
          EpiGate<false> E{(const bf16_t*)(ws + WS_GATE), (bf16_t*)(ws + WS_MRG), wtall};
          gemm_phase<EpiGate<false>, DepOrder, true, true>(lds, g, S, E); }
        { Gemm g{(const bf16_t*)(ws + WS_US), (const bf16_t*)(ws + WS_WPB), MT, DM, 512, true}; DepOrder S; S.init(MT, DM, G, ROT(16)); S.dep = nullptr; S.need = 0; S.sig = DEPC(3); S.tmo = tmo;
          EpiGate<true> E{(const bf16_t*)(ws + WS_GATE), (bf16_t*)(ws + WS_MRG), wtall};
          gemm_phase<EpiGate<true>, DepOrder, true, true>(lds, g, S, E); }
    }
    DSEAM(7);
    if (IN(8)) {
        Gemm g{(const bf16_t*)(ws + WS_MRG), (const bf16_t*)(ws + WS_WO), MT, DM, DM, true}; DepOrder S; S.init(MT, DM, G, ROT(24)); S.dep = DEPC(3); S.need = 4 * 8; S.sig = DEPC(4); S.tmo = tmo;
        EpiRes<false> E{HB, ST2, nullptr, 1.0f, wtall};
        gemm_phase<EpiRes<false>, DepOrder, true, true>(lds, g, S, E);
    }
    DSEAM(8);
    if (IN(9)) {
        Gemm g{HB, (const bf16_t*)(ws + WS_WQ), MT, DM, DM, true}; DepOrder S; S.init(MT, DM, G, ROT(32)); S.dep = DEPC(4); S.need = 4 * 8; S.sig = nullptr; S.tmo = tmo;
        EpiQ E{ST2, (bf16_t*)(ws + WS_QB), 1.44269504089f * 0.0625f};
        gemm_phase<EpiQ, DepOrder, true, true>(lds, g, S, E);
    }
    if (IN(9)) phase_prep<2>(args, lds, tid, wave, lane, 0, 1, (unsigned*)(ctl + CW_Q2));
    SEAM(9);
    if (IN(10)) { phase_attention(args, lds, tid, wave, lane, vcu, G); }
    SEAM(10);
    if (IN(11)) {
        Gemm g{(const bf16_t*)(ws + WS_OB), (const bf16_t*)(ws + WS_WCO), MT, DM, DM, true}; DepOrder S; S.init(MT, DM, G, ROT(0)); S.dep = nullptr; S.need = 0; S.sig = DEPC(5); S.tmo = tmo;
        EpiRes<false> E{HB, ST3, nullptr, 1.0f, wtall};
        gemm_phase<EpiRes<false>, DepOrder, true, true>(lds, g, S, E);
    }
    DSEAM(11);
    if (IN(12)) {
        Gemm g{HB, (const bf16_t*)(ws + WS_W13B), MT, 2 * DFF, DM, true}; DepOrder S; S.init(MT, 2 * DFF, G, ROT(8)); S.dep = DEPC(5); S.need = 4 * 8; S.sig = DEPC(6); S.tmo = tmo; S.skew = 1;
        EpiSwiglu E{(bf16_t*)(ws + WS_RACT), ST3, wtall};
        gemm_phase<EpiSwiglu, DepOrder, true, true>(lds, g, S, E);
    }
    DSEAM(12);
    if (IN(13)) {
        Gemm g{(const bf16_t*)(ws + WS_RACT), (const bf16_t*)(ws + WS_W2B), MT, DM, DFF, true}; DepOrder S; S.init(MT, DM, G, ROT(56)); S.dep = DEPC(6); S.need = 22 * 8; S.sig = DEPC(7); S.tmo = tmo;
        EpiRes<false> E{HB, ST0, nullptr, 0.5f, wtall};
        gemm_phase<EpiRes<false>, DepOrder, true, true>(lds, g, S, E);
    }
    DSEAM(13);
    if (IN(14)) { phase_final_q(args, lds, tid, wave, lane, bx, (unsigned*)(ctl + CW_QF), DEPC(7), tmo); }
#undef DEPC
#undef ROT
#undef IN
#undef SEAM
#undef DSEAM
}

extern "C" void kernel_launch(void* const* d_in, const int* in_sizes, int n_in, void* d_out, int out_size, void* d_ws, size_t ws_size, hipStream_t stream) {
    static int grid = 0;
    if (grid == 0) {
        if (n_in != 32 || (size_t)out_size != OUT_TOTAL || ws_size < WS_END) { fprintf(stderr, "kernel_launch: unexpected shapes: n_in %d out %d ws %zu (need %zu)\n", n_in, out_size, ws_size, (size_t)WS_END); grid = -1; return; }
        int dev = 0, cus = 0, per_cu = 0;
        if (hipGetDevice(&dev) != hipSuccess || hipDeviceGetAttribute(&cus, hipDeviceAttributeMultiprocessorCount, dev) != hipSuccess) { grid = -1; return; }
        if (hipFuncSetAttribute((const void*)fwd_kernel, hipFuncAttributeMaxDynamicSharedMemorySize, LDS_BYTES) != hipSuccess) { fprintf(stderr, "kernel_launch: hipFuncSetAttribute failed\n"); grid = -1; return; }
        if (hipOccupancyMaxActiveBlocksPerMultiprocessor(&per_cu, (const void*)fwd_kernel, NWAVES * 64, LDS_BYTES) != hipSuccess || per_cu < 1) { fprintf(stderr, "kernel_launch: occupancy query says %d blocks per CU\n", per_cu); grid = -1; (void)hipGetLastError(); return; }
        grid = cus;
    }
    if (grid < 0) return;
    (void)hipMemsetAsync((char*)d_ws + WS_CTL, 0, CTL_ZERO_BYTES, stream);
    Args a{};
    for (int i = 0; i < 32; ++i) a.in[i] = (const float*)d_in[i];
    a.out = (float*)d_out; a.ws = (unsigned char*)d_ws;
#if MK_PER_PHASE
    for (int p = 0; p < N_PHASES; ++p) { a.ph_lo = p; a.ph_hi = p + 1; hipLaunchKernelGGL(fwd_kernel, dim3(grid), dim3(NWAVES * 64), LDS_BYTES, stream, a); }
#else
    a.ph_lo = 0; a.ph_hi = N_PHASES;
    hipLaunchKernelGGL(fwd_kernel, dim3(grid), dim3(NWAVES * 64), LDS_BYTES, stream, a);
#endif
}
```

```cpp
#include <hip/hip_runtime.h>
#include <cstdio>
#include <cstdint>
namespace pg8 {
#define PG8_LAS __attribute__((address_space(3)))
typedef unsigned short bf16_t;
typedef short bf16x8 __attribute__((ext_vector_type(8)));
typedef float f32x4 __attribute__((ext_vector_type(4)));
typedef unsigned u32x4 __attribute__((ext_vector_type(4)));
constexpr int BM = 256, BK = 64, HALF = 128, HTB = HALF * BK * 2  , STAGE_BYTES = 8 * HTB, NXCD = 8, WGM = 8;

__host__ __device__ __forceinline__ int lds_byte(int r, int c) { const int st = (r >> 4) * 2 + (c >> 5), rr = r & 15, cc = c & 31, ob = rr * 64 + cc * 2; return st * 1024 + (ob ^ (((ob >> 9) & 1) << 5)); }
__host__ __device__ __forceinline__ void stage_rc(int b, int& R, int& C) { const int st = b / 1024, sb = b % 1024, swz = sb ^ (((sb >> 9) & 1) << 5); R = (st >> 1) * 16 + swz / 64; C = (st & 1) * 32 + (swz % 64) / 2; }
__host__ __device__ __forceinline__ int perm32(int rho) { const int n = rho >> 4, i = rho & 15; return 8 * (i >> 2) + 4 * n + (i & 3); }

__host__ __device__ __forceinline__ int inv_perm32(int x) { return 16 * ((x >> 2) & 1) + 4 * (x >> 3) + (x & 3); }
__host__ __device__ __forceinline__ int img_off_a(int rin, int c) { return (rin >> 7) * 16384 + lds_byte(rin & 127, c); }
__host__ __device__ __forceinline__ int img_off_w(int rin, int c) { const int r = rin & 127; return (rin >> 7) * 16384 + lds_byte((r & ~31) + inv_perm32(r & 31), c); }
__host__ __device__ __forceinline__ size_t hb_byte(int row, int col) { return (size_t)((row >> 8) * 16 + (col >> 6)) * 32768 + img_off_a(row & 255, col & 63); }
__host__ __device__ __forceinline__ size_t k512_byte(int row, int col) { return (size_t)((row >> 8) * 8 + (col >> 6)) * 32768 + img_off_a(row & 255, col & 63); }
__host__ __device__ __forceinline__ size_t gate_byte(int row, int col) { return (size_t)((row >> 8) * 32 + (col >> 6)) * 32768 + img_off_a(row & 255, col & 63); }
struct Unit { int pm, pn; };
struct Gemm { const bf16_t* A; const bf16_t* Bt; int M, N, K; bool ablk = false; };

struct StaticOrder {
    int nM, nN, nwg, G, c;
    __host__ __device__ void init(int M, int N, int G_, int c_) { nM = M / BM; nN = N / BM; nwg = nM * nN; G = G_; c = c_; }
    __host__ __device__ bool next(int i, Unit& u) const {
        const long L = (long)i * G + c; if (L >= nwg) return false;
        int wgid = (int)L; { const int q = nwg / NXCD, r = nwg % NXCD, xcd = wgid % NXCD, off = wgid / NXCD; wgid = (xcd < r ? xcd * (q + 1) : r * (q + 1) + (xcd - r) * q) + off; }
        const int nig = WGM * nN, gid = wgid / nig, fm = gid * WGM, gsz = (nM - fm) < WGM ? (nM - fm) : WGM;
        u.pm = fm + ((wgid % nig) % gsz); u.pn = (wgid % nig) / gsz; return true;
    }
    __device__ __forceinline__ void a_ready(const Unit&) const {}
    __device__ __forceinline__ void done(const Unit&) const {}
    static constexpr bool HAS_SIG = false;
    __device__ __forceinline__ void signal(int, int) const {}
};
struct DepOrder : StaticOrder {
    static constexpr bool HAS_SIG = true;
    const unsigned* dep; unsigned need; unsigned* sig; unsigned* tmo; int skew = 0; mutable int okpm = -1;
    __device__ bool next(int i, Unit& u) const {
        if (G != 256 || nM != 130) return StaticOrder::next(i, u);
        const int x = c & 7, k = c >> 3, nP = 16 * nN; int li = i * 32 + k;
        if (skew) {
            if (k == 6 && i >= 9) return false;
            if ((k == 17 || k == 18) && i == 11) li = 32 * (9 + (k - 17)) + 6;
        }
        if (li < nP) { const int per = 8 * nN, g = li / per, w = li - g * per; u.pm = 16 * x + 8 * g + (w & 7); u.pn = w >> 3; return true; }
        const int sidx = (li - nP) * 8 + x;
        if (sidx >= 2 * nN) return false;
        u.pm = 128 + (sidx & 1); u.pn = sidx >> 1; return true;
    }
    __device__ __forceinline__ void a_ready(const Unit& u) const {
        if (dep == nullptr || u.pm == okpm) return;
        okpm = u.pm;
        if (threadIdx.x < 64) {
            unsigned polls = 0;
            while ((unsigned)__builtin_amdgcn_readfirstlane(__hip_atomic_load(dep + 64 * u.pm, __ATOMIC_RELAXED, __HIP_MEMORY_SCOPE_AGENT)) < need) {
                if ((++polls & 1023u) == 0u) { if (__builtin_amdgcn_readfirstlane(__hip_atomic_load(tmo, __ATOMIC_RELAXED, __HIP_MEMORY_SCOPE_AGENT)) != 0u) break;
                    if (polls > (1u << 22)) { if (threadIdx.x == 0) __hip_atomic_store(tmo, 1u, __ATOMIC_RELAXED, __HIP_MEMORY_SCOPE_AGENT); break; } }
                __builtin_amdgcn_s_sleep(2); }
            __builtin_amdgcn_fence(__ATOMIC_ACQUIRE, "agent");
            asm volatile("s_waitcnt vmcnt(0)" ::: "memory");
        }
        asm volatile("" ::: "memory"); __builtin_amdgcn_s_barrier(); asm volatile("" ::: "memory");
    }
    __device__ __forceinline__ void signal(int pm, int lane) const { if (sig != nullptr && lane == 0) __hip_atomic_fetch_add(sig + 64 * pm, 1u, __ATOMIC_RELAXED, __HIP_MEMORY_SCOPE_AGENT); }
};

typedef __bf16 bf16x2_t __attribute__((ext_vector_type(2)));
typedef float f32x2_t __attribute__((ext_vector_type(2)));
__device__ __forceinline__ unsigned cvt_pk_bf16(float lo, float hi) { const f32x2_t v = {lo, hi}; const bf16x2_t b = __builtin_convertvector(v, bf16x2_t); return __builtin_bit_cast(unsigned, b); }
typedef float f32x2 __attribute__((ext_vector_type(2)));
constexpr float RMS_EPS = 1e-6f;
__device__ __forceinline__ float fast_sigmoid(float x) { return __builtin_amdgcn_rcpf(1.0f + __builtin_amdgcn_exp2f(-1.44269504089f * x)); }
__device__ __forceinline__ float silu_f(float a) { return a * fast_sigmoid(a); }
__device__ __forceinline__ float gelu_tanh_f(float x) { return x * fast_sigmoid(1.5957691216f * (x + 0.044715f * x * x * x)); }
__device__ __forceinline__ f32x2 sigmoid2(f32x2 x) { const f32x2 t = x * -1.44269504089f; f32x2 e; e.x = __builtin_amdgcn_exp2f(t.x); e.y = __builtin_amdgcn_exp2f(t.y);
    const f32x2 d = e + 1.0f; f32x2 r; r.x = __builtin_amdgcn_rcpf(d.x); r.y = __builtin_amdgcn_rcpf(d.y); return r; }
__device__ __forceinline__ f32x2 gelu_tanh2(f32x2 x) { const f32x2 y = (x * x) * 0.044715f + 1.0f; return x * sigmoid2((y * x) * 1.5957691216f); }
__device__ __forceinline__ float bf_lo(unsigned w) { return __builtin_bit_cast(float, w << 16); }
__device__ __forceinline__ float bf_hi(unsigned w) { return __builtin_bit_cast(float, w & 0xffff0000u); }
__device__ __forceinline__ float row_rinv(const float* st, int row) {
    const f32x4* p = (const f32x4*)(st + (size_t)row * 16);
    const f32x4 a = p[0], b = p[1], c = p[2], d = p[3];
    const float s = (((a.x + a.y) + (a.z + a.w)) + ((b.x + b.y) + (b.z + b.w))) + (((c.x + c.y) + (c.z + c.w)) + ((d.x + d.y) + (d.z + d.w)));
    return __builtin_amdgcn_rsqf(s * (1.0f / 1024.0f) + RMS_EPS);
}
__device__ __forceinline__ void rows_rinv(const float* st, int row0, int fq, float (&r)[2][4]) {
    f32x4 p[2][4];
#pragma unroll
    for (int ai = 0; ai < 2; ++ai)
#pragma unroll
        for (int m = 0; m < 4; ++m) p[ai][m] = *(const f32x4*)(st + (size_t)(row0 + ai * HALF + m * 16) * 16 + 4 * fq);
#pragma unroll
    for (int ai = 0; ai < 2; ++ai)
#pragma unroll
        for (int m = 0; m < 4; ++m) { float s = (p[ai][m].x + p[ai][m].y) + (p[ai][m].z + p[ai][m].w); s += __shfl_xor(s, 16); s += __shfl_xor(s, 32); r[ai][m] = __builtin_amdgcn_rsqf(s * (1.0f / 1024.0f) + RMS_EPS); }
}
__device__ __forceinline__ u32x4 pack8(const float (&o)[8]) { u32x4 w; w.x = cvt_pk_bf16(o[0], o[1]); w.y = cvt_pk_bf16(o[2], o[3]); w.z = cvt_pk_bf16(o[4], o[5]); w.w = cvt_pk_bf16(o[6], o[7]); return w; }

__device__ __forceinline__ void store16_sel(void* p, u32x4 v, bool wt) { if (wt) asm volatile("global_store_dwordx4 %0, %1, off sc1\n\ts_nop 1" :: "v"(p), "v"(v) : "memory"); else *(u32x4*)p = v; }
__device__ __forceinline__ void store16_wt(void* p, u32x4 v) { asm volatile("global_store_dwordx4 %0, %1, off sc1\n\ts_nop 1" :: "v"(p), "v"(v) : "memory"); }
struct EpiSwiglu {
    static constexpr bool PERM = true, AFTER_DRAIN = false;
    bf16_t* O; const float* st; bool wtall;
    __device__ __forceinline__ void operator()(const f32x4 (&acc)[2][2][4][2], const Unit& u, int wr, int wc, int fr_, int fq_) const {
        int fr = fr_, fq = fq_; asm volatile("" : "+v"(fr), "+v"(fq));
        const int row0 = u.pm * BM + wr * 64 + fr;
        unsigned char* const Ob = (unsigned char*)O + (size_t)(u.pm * (2816 / 64) + u.pn * 2 + (wc >> 1)) * 32768;
        float rr[2][4]; rows_rinv(st, row0, fq, rr);
#pragma unroll
        for (int ai = 0; ai < 2; ++ai)
#pragma unroll
            for (int m = 0; m < 4; ++m) {
                const int row = row0 + ai * HALF + m * 16;
                const float r = rr[ai][m];
                float o[8];
#pragma unroll
                for (int n = 0; n < 2; ++n)
#pragma unroll
                    for (int j = 0; j < 4; j += 2) { const f32x2 a = (f32x2){acc[ai][0][m][n][j], acc[ai][0][m][n][j + 1]} * r, b = (f32x2){acc[ai][1][m][n][j], acc[ai][1][m][n][j + 1]} * r;
                        const f32x2 v = (a * sigmoid2(a)) * b; o[n * 4 + j] = v.x; o[n * 4 + j + 1] = v.y; }
                store16_sel(Ob + img_off_a(wr * 64 + fr + ai * HALF + m * 16, (wc & 1) * 32 + 8 * fq), pack8(o), wtall || u.pm >= 128);
                asm volatile("" ::: "memory");
            }
    }
};
template <bool FINAL> struct EpiRes {
    static constexpr bool PERM = true, AFTER_DRAIN = false;
    bf16_t* hb; float* st; float* out; float scale; bool wtall;
    __device__ __forceinline__ void operator()(const f32x4 (&acc)[2][2][4][2], const Unit& u, int wr, int wc, int fr_, int fq_) const {
        int fr = fr_, fq = fq_; asm volatile("" : "+v"(fr), "+v"(fq));
        const int row0 = u.pm * BM + wr * 64 + fr, col0 = u.pn * BM + wc * 32 + 8 * fq;
#pragma unroll
        for (int ai = 0; ai < 2; ++ai) {
            u32x4 hv[4][2];
#pragma unroll
            for (int m = 0; m < 4; ++m)
#pragma unroll
                for (int bj = 0; bj < 2; ++bj) hv[m][bj] = *(const u32x4*)((const unsigned char*)hb + hb_byte(row0 + ai * HALF + m * 16, col0 + bj * HALF));
#pragma unroll
            for (int m = 0; m < 4; ++m) {
                const int row = row0 + ai * HALF + m * 16;
                float ss = 0.f;
#pragma unroll
                for (int bj = 0; bj < 2; ++bj) {
                    bf16_t* hp = (bf16_t*)((unsigned char*)hb + hb_byte(row, col0 + bj * HALF));
                    const u32x4 b = hv[m][bj];
                    f32x4 v0 = acc[ai][bj][m][0] * scale, v1 = acc[ai][bj][m][1] * scale;
                    v0.x += bf_lo(b.x); v0.y += bf_hi(b.x); v0.z += bf_lo(b.y); v0.w += bf_hi(b.y); v1.x += bf_lo(b.z); v1.y += bf_hi(b.z); v1.z += bf_lo(b.w); v1.w += bf_hi(b.w);
                    if (FINAL) { float* op = out + (size_t)row * 1024 + col0 + bj * HALF; *(f32x4*)op = v0; *(f32x4*)(op + 4) = v1; }
                    else { u32x4 w; w.x = cvt_pk_bf16(v0.x, v0.y); w.y = cvt_pk_bf16(v0.z, v0.w); w.z = cvt_pk_bf16(v1.x, v1.y); w.w = cvt_pk_bf16(v1.z, v1.w); store16_sel(hp, w, wtall || u.pm >= 128);
                        ss += ((v0.x * v0.x + v0.y * v0.y) + (v0.z * v0.z + v0.w * v0.w)) + ((v1.x * v1.x + v1.y * v1.y) + (v1.z * v1.z + v1.w * v1.w)); }
                }
                if (!FINAL) { ss += __shfl_xor(ss, 16); ss += __shfl_xor(ss, 32); if (fq == 0) __hip_atomic_store(st + (size_t)row * 16 + u.pn * 4 + wc, ss, __ATOMIC_RELAXED, __HIP_MEMORY_SCOPE_AGENT); }
            }
            asm volatile("" ::: "memory");
        }
    }
};
struct EpiZ {
    static constexpr bool PERM = true, AFTER_DRAIN = false;
    const float* st; bf16_t* xa; bf16_t* uu; bf16_t* vv; bf16_t* gate; float* stv; const float* b_gate; float* poolp; float* pools; int pn_off; bool wtall;
    __device__ __forceinline__ void operator()(const f32x4 (&acc)[2][2][4][2], const Unit& u, int wr, int wc, int fr_, int fq_) const {
        int fr = fr_, fq = fq_; asm volatile("" : "+v"(fr), "+v"(fq));
        const int row0 = u.pm * BM + wr * 64 + fr; const int pn = u.pn + pn_off;
        const int kind = pn < 2 ? 0 : (pn < 4 ? 1 : (pn < 6 ? 2 : 3));
        const int tbase = pn < 2 ? 0 : (pn < 4 ? 2 : (pn < 6 ? 4 : 6));
        const int lc0 = (pn - tbase) * BM + wc * 32 + 8 * fq;
        float rr[2][4]; rows_rinv(st, row0, fq, rr);
        if (kind == 0) {
#pragma unroll
            for (int ai = 0; ai < 2; ++ai)
#pragma unroll
                for (int m = 0; m < 4; ++m) {
                    const int row = row0 + ai * HALF + m * 16; const float r = rr[ai][m];
                    float* pdst = nullptr;
                    if (row < 32768) { const int t = row & 4095; if (t >= 4081) pdst = poolp + (size_t)((row >> 12) * 15 + (t - 4081)) * 512; }
                    else { const int sr = row - 32768, t = sr & 15; if (t >= 1) pdst = pools + (size_t)((sr >> 4) * 15 + (t - 1)) * 512; }
#pragma unroll
                    for (int bj = 0; bj < 2; ++bj) {
                        const f32x4 v0 = acc[ai][bj][m][0] * r, v1 = acc[ai][bj][m][1] * r; const int c = lc0 + bj * HALF;
                        u32x4 w; w.x = cvt_pk_bf16(v0.x, v0.y); w.y = cvt_pk_bf16(v0.z, v0.w); w.z = cvt_pk_bf16(v1.x, v1.y); w.w = cvt_pk_bf16(v1.z, v1.w);
                        *(u32x4*)(xa + (size_t)row * 512 + c) = w;
                        if (pdst) { *(f32x4*)(pdst + c) = v0; *(f32x4*)(pdst + c + 4) = v1; }
                    }
                }
        } else if (kind == 1) {
#pragma unroll
            for (int ai = 0; ai < 2; ++ai)
#pragma unroll
                for (int m = 0; m < 4; ++m) {
                    const int row = row0 + ai * HALF + m * 16; const float r = rr[ai][m];
#pragma unroll
                    for (int bj = 0; bj < 2; ++bj) {
                        float o[8];
#pragma unroll
                        for (int n = 0; n < 2; ++n)
#pragma unroll
                            for (int j = 0; j < 4; j += 2) { const f32x2 v = gelu_tanh2((f32x2){acc[ai][bj][m][n][j], acc[ai][bj][m][n][j + 1]} * r); o[n * 4 + j] = v.x; o[n * 4 + j + 1] = v.y; }
                        *(u32x4*)(uu + (size_t)row * 512 + lc0 + bj * HALF) = pack8(o);
                    }
                }
        } else if (kind == 2) {
#pragma unroll
            for (int ai = 0; ai < 2; ++ai)
#pragma unroll
                for (int m = 0; m < 4; ++m) {
                    const int row = row0 + ai * HALF + m * 16; const float r = rr[ai][m];
                    float s1 = 0.f, s2 = 0.f;
#pragma unroll
                    for (int bj = 0; bj < 2; ++bj) {
                        float o[8];
#pragma unroll
                        for (int n = 0; n < 2; ++n)
#pragma unroll
                            for (int j = 0; j < 4; j += 2) { const f32x2 g = gelu_tanh2((f32x2){acc[ai][bj][m][n][j], acc[ai][bj][m][n][j + 1]} * r); o[n * 4 + j] = g.x; o[n * 4 + j + 1] = g.y; s1 += g.x + g.y; s2 += g.x * g.x + g.y * g.y; }
                        *(u32x4*)(vv + (size_t)row * 512 + lc0 + bj * HALF) = pack8(o);
                    }
                    s1 += __shfl_xor(s1, 16); s1 += __shfl_xor(s1, 32); s2 += __shfl_xor(s2, 16); s2 += __shfl_xor(s2, 32);
                    if (fq == 0) { f32x2 sv; sv.x = s1; sv.y = s2; *(f32x2*)(stv + (size_t)row * 16 + ((pn - 4) * 4 + wc) * 2) = sv; }
                }
        } else {
            f32x4 bv[2][2];
#pragma unroll
            for (int bj = 0; bj < 2; ++bj)
#pragma unroll
                for (int n = 0; n < 2; ++n) bv[bj][n] = *(const f32x4*)(b_gate + lc0 + bj * HALF + 4 * n);
#pragma unroll
            for (int ai = 0; ai < 2; ++ai)
#pragma unroll
                for (int m = 0; m < 4; ++m) {
                    const int row = row0 + ai * HALF + m * 16; const float r = rr[ai][m];
#pragma unroll
                    for (int bj = 0; bj < 2; ++bj) {
                        float o[8];
#pragma unroll
                        for (int n = 0; n < 2; ++n)
#pragma unroll
                            for (int j = 0; j < 4; j += 2) { const f32x2 v = sigmoid2((f32x2){acc[ai][bj][m][n][j], acc[ai][bj][m][n][j + 1]} * r + (f32x2){bv[bj][n][j], bv[bj][n][j + 1]}); o[n * 4 + j] = v.x; o[n * 4 + j + 1] = v.y; }
                        store16_sel((unsigned char*)gate + gate_byte(row, lc0 + bj * HALF), pack8(o), wtall || u.pm >= 128);
                    }
                }
        }
    }
};
template <bool ADD> struct EpiGate {
    static constexpr bool PERM = true, AFTER_DRAIN = false;
    const bf16_t* gate; bf16_t* mrg; bool wtall;
    __device__ __forceinline__ void operator()(const f32x4 (&acc)[2][2][4][2], const Unit& u, int wr, int wc, int fr_, int fq_) const {
        int fr = fr_, fq = fq_; asm volatile("" : "+v"(fr), "+v"(fq));
        const int row0 = u.pm * BM + wr * 64 + fr, col0 = u.pn * BM + wc * 32 + 8 * fq;
#pragma unroll
        for (int ai = 0; ai < 2; ++ai)
#pragma unroll
            for (int mp = 0; mp < 2; ++mp) {
                u32x4 gv[2][2], tv[2][2];
#pragma unroll
                for (int mm = 0; mm < 2; ++mm)
#pragma unroll
                    for (int bj = 0; bj < 2; ++bj) { const int row = row0 + ai * HALF + (2 * mp + mm) * 16, c = col0 + bj * HALF;
                        gv[mm][bj] = *(const u32x4*)((const unsigned char*)gate + gate_byte(row, (ADD ? 1024 : 0) + c));
                        if (ADD) tv[mm][bj] = *(const u32x4*)((const unsigned char*)mrg + hb_byte(row, c)); }
#pragma unroll
                for (int mm = 0; mm < 2; ++mm) {
                    const int m = 2 * mp + mm; const int row = row0 + ai * HALF + m * 16;
#pragma unroll
                    for (int bj = 0; bj < 2; ++bj) {
                        const int c = col0 + bj * HALF;
                        const u32x4 g = gv[mm][bj];
                        float o[8];
                        o[0] = acc[ai][bj][m][0].x * bf_lo(g.x); o[1] = acc[ai][bj][m][0].y * bf_hi(g.x); o[2] = acc[ai][bj][m][0].z * bf_lo(g.y); o[3] = acc[ai][bj][m][0].w * bf_hi(g.y);
                        o[4] = acc[ai][bj][m][1].x * bf_lo(g.z); o[5] = acc[ai][bj][m][1].y * bf_hi(g.z); o[6] = acc[ai][bj][m][1].z * bf_lo(g.w); o[7] = acc[ai][bj][m][1].w * bf_hi(g.w);
                        bf16_t* mpt = (bf16_t*)((unsigned char*)mrg + hb_byte(row, c));
                        if (ADD) { const u32x4 t = tv[mm][bj];
                            o[0] += bf_lo(t.x); o[1] += bf_hi(t.x); o[2] += bf_lo(t.y); o[3] += bf_hi(t.y); o[4] += bf_lo(t.z); o[5] += bf_hi(t.z); o[6] += bf_lo(t.w); o[7] += bf_hi(t.w); }
                        if (ADD) store16_sel(mpt, pack8(o), wtall || u.pm >= 128); else *(u32x4*)mpt = pack8(o);
                    }
                }
                asm volatile("" ::: "memory");
            }
    }
};
struct EpiQ {
    static constexpr bool PERM = true, AFTER_DRAIN = false;
    const float* st; bf16_t* q; float qscale;
    __device__ __forceinline__ void operator()(const f32x4 (&acc)[2][2][4][2], const Unit& u, int wr, int wc, int fr_, int fq_) const {
        int fr = fr_, fq = fq_; asm volatile("" : "+v"(fr), "+v"(fq));
        const int row0 = u.pm * BM + wr * 64 + fr, col0 = u.pn * BM + wc * 32 + 8 * fq;
        float rr[2][4]; rows_rinv(st, row0, fq, rr);
#pragma unroll
        for (int ai = 0; ai < 2; ++ai)
#pragma unroll
            for (int m = 0; m < 4; ++m) {
                const int row = row0 + ai * HALF + m * 16; const float r = rr[ai][m] * qscale;
#pragma unroll
                for (int bj = 0; bj < 2; ++bj) {
                    const f32x4 v0 = acc[ai][bj][m][0] * r, v1 = acc[ai][bj][m][1] * r;
                    u32x4 w; w.x = cvt_pk_bf16(v0.x, v0.y); w.y = cvt_pk_bf16(v0.z, v0.w); w.z = cvt_pk_bf16(v1.x, v1.y); w.w = cvt_pk_bf16(v1.z, v1.w);
                    *(u32x4*)((unsigned char*)q + hb_byte(row, col0 + bj * HALF)) = w;
                }
            }
    }
};
struct EpiKV {
    static constexpr bool PERM = true, AFTER_DRAIN = false;
    float* out_k; float* out_v; bf16_t* kb;
    __device__ __forceinline__ void operator()(const f32x4 (&acc)[2][2][4][2], const Unit& u, int wr, int wc, int fr_, int fq_) const {
        int fr = fr_, fq = fq_; asm volatile("" : "+v"(fr), "+v"(fq));
        const int row0 = u.pm * BM + wr * 64 + fr; const bool isk = u.pn < 4;
        const int col0 = (isk ? u.pn : u.pn - 4) * BM + wc * 32 + 8 * fq; float* of = isk ? out_k : out_v;
#pragma unroll
        for (int ai = 0; ai < 2; ++ai)
#pragma unroll
            for (int m = 0; m < 4; ++m) {
                const int row = row0 + ai * HALF + m * 16;
#pragma unroll
                for (int bj = 0; bj < 2; ++bj) {
                    const f32x4 v0 = acc[ai][bj][m][0], v1 = acc[ai][bj][m][1]; const int c = col0 + bj * HALF;
                    float* op = of + (size_t)row * 1024 + c; if (isk) { __builtin_nontemporal_store(v0, (f32x4*)op); __builtin_nontemporal_store(v1, (f32x4*)(op + 4)); } else { *(f32x4*)op = v0; *(f32x4*)(op + 4) = v1; }
                    if (isk) { u32x4 w; w.x = cvt_pk_bf16(v0.x, v0.y); w.y = cvt_pk_bf16(v0.z, v0.w); w.z = cvt_pk_bf16(v1.x, v1.y); w.w = cvt_pk_bf16(v1.z, v1.w); *(u32x4*)(kb + ((size_t)((row >> 8) * 4 + (c >> 8)) * 256 + (row & 255)) * 256 + (c & 255)) = w; }
                }
            }
    }
};

__device__ __forceinline__ void glds16x2_sv(const void* sbase, unsigned voff0, unsigned voff1, unsigned lds_dst) {
    unsigned keep;
    asm volatile("s_mov_b32 %0, m0\n\ts_mov_b32 m0, %4\n\ts_nop 0\n\tglobal_load_lds_dwordx4 %1, %3\n\ts_add_u32 m0, %4, 0x2000\n\ts_nop 0\n\tglobal_load_lds_dwordx4 %2, %3\n\ts_mov_b32 m0, %0"
                 : "=&s"(keep) : "v"(voff0), "v"(voff1), "s"(sbase), "s"(lds_dst) : "memory", "scc");
}
template <class Epi, class Sched, bool ALIGN_EPI = false, bool SP2 = false>
__device__ __forceinline__ void gemm_phase(PG8_LAS unsigned char* lds, const Gemm g, const Sched& S, const Epi& E) {
    const int tid = threadIdx.x, wid = __builtin_amdgcn_readfirstlane(tid >> 6), lane = tid & 63, wr = wid >> 2, wc = wid & 3, fr = lane & 15, fq = lane >> 4;
    const int K = g.K, nt = K / BK;
    unsigned voffA[2], voffB[2];
#pragma unroll
    for (int i = 0; i < 2; ++i) { int R, C; stage_rc(tid * 16 + i * 8192, R, C); const int Rb = Epi::PERM ? ((R & ~31) + perm32(R & 31)) : R;
        voffA[i] = g.ablk ? (unsigned)(tid * 16 + i * 8192) : (unsigned)(R * K + C) * 2u; voffB[i] = (unsigned)(tid * 16 + i * 8192); (void)Rb; }
    const size_t kstep = (size_t)(BK * 2);
    const size_t hstep = (size_t)HALF * K * 2;
    const size_t tstep = 2 * hstep;
    const size_t bkstep = (size_t)(BM * BK * 2), bhstep = (size_t)(HALF * BK * 2), btstep = (size_t)nt * (BM * BK * 2);
    const size_t akstep = g.ablk ? (size_t)(BM * BK * 2) : kstep, ahstep = g.ablk ? (size_t)(HALF * BK * 2) : hstep, atstep = g.ablk ? (size_t)nt * (BM * BK * 2) : tstep;
    const unsigned ldsw = (unsigned)wid * 1024u;
    const unsigned ldsb = (unsigned)__builtin_amdgcn_readfirstlane((int)((unsigned)(size_t)lds + ldsw));
    const int aoff = lds_byte(wr * 64 + fr, fq * 8), boff = lds_byte(wc * 32 + fr, fq * 8);
#define PG8_SA(b, h) (((b) * 2 + (h)) * HTB)
#define PG8_SB(b, h) ((4 + (b) * 2 + (h)) * HTB)
#define PG8_STAGE(bufoff, gbase, voff) glds16x2_sv((const void*)(gbase), (voff)[0], (voff)[1], ldsb + (unsigned)(bufoff))
#define PG8_LDA(dst, b, h) do { _Pragma("unroll") for (int m = 0; m < 4; ++m) _Pragma("unroll") for (int k = 0; k < 2; ++k) dst[m][k] = *(const PG8_LAS bf16x8*)(lds + PG8_SA(b, h) + aoff + m * 2048 + k * 1024); } while (0)
#define PG8_LDB(dst, b, h) do { _Pragma("unroll") for (int n = 0; n < 2; ++n) _Pragma("unroll") for (int k = 0; k < 2; ++k) dst[n][k] = *(const PG8_LAS bf16x8*)(lds + PG8_SB(b, h) + boff + n * 2048 + k * 1024); } while (0)
#define PG8_MMA(ai, bj, At, Bt) do { __builtin_amdgcn_s_setprio(1); _Pragma("unroll") for (int m = 0; m < 4; ++m) _Pragma("unroll") for (int n = 0; n < 2; ++n) _Pragma("unroll") for (int k = 0; k < 2; ++k) \
        acc[ai][bj][m][n] = __builtin_amdgcn_mfma_f32_16x16x32_bf16(Bt[n][k], At[m][k], acc[ai][bj][m][n], 0, 0, 0); __builtin_amdgcn_s_setprio(0); } while (0)
#define PG8_ZERO(ai) do { if (t == 0) { _Pragma("unroll") for (int b = 0; b < 2; ++b) _Pragma("unroll") for (int m = 0; m < 4; ++m) _Pragma("unroll") for (int n = 0; n < 2; ++n) acc[ai][b][m][n] = (f32x4){0.f, 0.f, 0.f, 0.f}; } } while (0)
#define PG8_WAIT_V(n) asm volatile("s_waitcnt vmcnt(" #n ")" ::: "memory")
#define PG8_WAIT_L(n) asm volatile("s_waitcnt lgkmcnt(" #n ")" ::: "memory")
#define PG8_BAR __builtin_amdgcn_s_barrier()
#define PG8_SCHED __builtin_amdgcn_sched_barrier(0)
    Unit cur, nxt; int ui = 0; int pend = -1;
    if (!S.next(0, cur)) return;
    f32x4 acc[2][2][4][2];
#pragma unroll
    for (int a = 0; a < 2; ++a)
#pragma unroll
        for (int b = 0; b < 2; ++b)
#pragma unroll
            for (int m = 0; m < 4; ++m)
#pragma unroll
                for (int n = 0; n < 2; ++n) acc[a][b][m][n] = (f32x4){0.f, 0.f, 0.f, 0.f};
    bf16x8 At[4][2], B0[2][2], B1[2][2];
    const char* cA = (const char*)g.A + (size_t)cur.pm * atstep; const char* cB = (const char*)g.Bt + (size_t)cur.pn * btstep;
    S.a_ready(cur);
    if constexpr (SP2) {
        PG8_STAGE(PG8_SB(0, 0), cB, voffB); PG8_STAGE(PG8_SB(0, 1), cB + bhstep, voffB); PG8_STAGE(PG8_SA(0, 0), cA, voffA); PG8_STAGE(PG8_SA(0, 1), cA + ahstep, voffA);
        if (wr == 1) PG8_BAR;
        PG8_WAIT_V(2); PG8_BAR;
        PG8_STAGE(PG8_SB(1, 0), cB + bkstep, voffB); PG8_STAGE(PG8_SA(1, 0), cA + akstep, voffA); PG8_STAGE(PG8_SB(1, 1), cB + bhstep + bkstep, voffB);
        PG8_WAIT_V(6); PG8_BAR;
    } else {
        PG8_STAGE(PG8_SB(0, 0), cB, voffB); PG8_STAGE(PG8_SA(0, 0), cA, voffA); PG8_STAGE(PG8_SB(0, 1), cB + bhstep, voffB); PG8_STAGE(PG8_SA(0, 1), cA + ahstep, voffA);
        if (wr == 1) PG8_BAR;
        PG8_WAIT_V(4); PG8_BAR;
        PG8_STAGE(PG8_SB(1, 0), cB + bkstep, voffB); PG8_STAGE(PG8_SA(1, 0), cA + akstep, voffA); PG8_STAGE(PG8_SB(1, 1), cB + bhstep + bkstep, voffB);
        PG8_WAIT_V(6); PG8_BAR;
    }
    for (;;) {
        const bool has_next = S.next(ui + 1, nxt);
        const char* nA = has_next ? (const char*)g.A + (size_t)nxt.pm * atstep : cA; const char* nB = has_next ? (const char*)g.Bt + (size_t)nxt.pn * btstep : cB;
        for (int t = 0; t < nt; t += 2) {
            const bool last = (t == nt - 2);
            if constexpr (Sched::HAS_SIG) { if (t == 2 && pend >= 0) { S.signal(pend, lane); pend = -1; } }
            const char* a1 = cA + (size_t)(t + 1) * akstep;
            const char* a2 = last ? nA : cA + (size_t)(t + 2) * akstep; const char* b2 = last ? nB : cB + (size_t)(t + 2) * bkstep;
            const char* a3 = a2 + akstep; const char* b3 = b2 + bkstep;
            if (last && has_next) S.a_ready(nxt);
            if constexpr (SP2) {
            PG8_LDB(B0, 0, 0); PG8_LDB(B1, 0, 1); PG8_SCHED; PG8_LDA(At, 0, 0); PG8_STAGE(PG8_SA(1, 1), a1 + ahstep, voffA); PG8_ZERO(0);
            PG8_WAIT_V(8); PG8_WAIT_L(0); PG8_BAR; PG8_MMA(0, 0, At, B0); PG8_MMA(0, 1, At, B1); PG8_BAR; PG8_SCHED;
            PG8_LDA(At, 0, 1); PG8_STAGE(PG8_SB(0, 0), b2, voffB); PG8_STAGE(PG8_SB(0, 1), b2 + bhstep, voffB); PG8_STAGE(PG8_SA(0, 0), a2, voffA); PG8_ZERO(1);
            PG8_WAIT_V(8); PG8_WAIT_L(0); PG8_BAR; PG8_MMA(1, 0, At, B0); PG8_MMA(1, 1, At, B1); PG8_BAR; PG8_SCHED;
            PG8_LDB(B0, 1, 0); PG8_LDB(B1, 1, 1); PG8_SCHED; PG8_LDA(At, 1, 0); PG8_STAGE(PG8_SA(0, 1), a2 + ahstep, voffA);
            PG8_WAIT_V(8); PG8_WAIT_L(0); PG8_BAR; PG8_MMA(0, 0, At, B0); PG8_MMA(0, 1, At, B1); PG8_BAR; PG8_SCHED;
            PG8_LDA(At, 1, 1); PG8_STAGE(PG8_SB(1, 0), b3, voffB); PG8_STAGE(PG8_SB(1, 1), b3 + bhstep, voffB); PG8_STAGE(PG8_SA(1, 0), a3, voffA);
            PG8_WAIT_V(8); PG8_WAIT_L(0); PG8_BAR; PG8_MMA(1, 0, At, B0); PG8_MMA(1, 1, At, B1); PG8_BAR; PG8_SCHED;
            } else {
            PG8_LDB(B0, 0, 0); PG8_SCHED; PG8_LDA(At, 0, 0); PG8_STAGE(PG8_SA(1, 1), a1 + ahstep, voffA);
            PG8_WAIT_L(8); PG8_BAR; PG8_WAIT_L(0); PG8_MMA(0, 0, At, B0); PG8_BAR; PG8_SCHED;
            PG8_LDB(B1, 0, 1); PG8_STAGE(PG8_SB(0, 0), b2, voffB);
            PG8_BAR; PG8_WAIT_L(0); PG8_MMA(0, 1, At, B1); PG8_BAR;
            PG8_LDA(At, 0, 1); PG8_STAGE(PG8_SA(0, 0), a2, voffA);
            PG8_BAR; PG8_WAIT_L(0); PG8_MMA(1, 0, At, B0); PG8_BAR; PG8_SCHED;
            PG8_STAGE(PG8_SB(0, 1), b2 + bhstep, voffB);
            PG8_WAIT_V(6); PG8_BAR; PG8_MMA(1, 1, At, B1); PG8_BAR;
            PG8_LDB(B0, 1, 0); PG8_SCHED; PG8_LDA(At, 1, 0); PG8_STAGE(PG8_SA(0, 1), a2 + ahstep, voffA);
            PG8_WAIT_L(8); PG8_BAR; PG8_WAIT_L(0); PG8_MMA(0, 0, At, B0); PG8_BAR; PG8_SCHED;
            PG8_LDB(B1, 1, 1); PG8_STAGE(PG8_SB(1, 0), b3, voffB);
            PG8_BAR; PG8_WAIT_L(0); PG8_MMA(0, 1, At, B1); PG8_BAR;
            PG8_LDA(At, 1, 1); PG8_STAGE(PG8_SA(1, 0), a3, voffA);
            PG8_BAR; PG8_WAIT_L(0); PG8_MMA(1, 0, At, B0); PG8_BAR; PG8_SCHED;
            PG8_STAGE(PG8_SB(1, 1), b3 + bhstep, voffB);
            PG8_WAIT_V(6); PG8_BAR; PG8_MMA(1, 1, At, B1); PG8_BAR;
            }
        }
        if constexpr (ALIGN_EPI) { if (wr == 0) PG8_BAR; }
        if constexpr (!Epi::AFTER_DRAIN) { E(acc, cur, wr, wc, fr, fq); S.done(cur); }
        if constexpr (Sched::HAS_SIG) pend = cur.pm;
        if (!has_next) break;
        if constexpr (!SP2) {
#pragma unroll
        for (int a = 0; a < 2; ++a)
#pragma unroll
            for (int b = 0; b < 2; ++b)
#pragma unroll
                for (int m = 0; m < 4; ++m)
#pragma unroll
                    for (int n = 0; n < 2; ++n) acc[a][b][m][n] = (f32x4){0.f, 0.f, 0.f, 0.f};
        }
        cur = nxt; cA = nA; cB = nB; ++ui;
        if constexpr (ALIGN_EPI) { if (wr == 1) PG8_BAR; }
    }
    PG8_WAIT_V(0);
    if constexpr (Sched::HAS_SIG) { if (pend >= 0) { S.signal(pend, lane); pend = -1; } }
    if constexpr (!ALIGN_EPI) { if (wr == 0) PG8_BAR; }
    PG8_BAR;
    if constexpr (Epi::AFTER_DRAIN) { E.fused(acc, cur, wr, wc, fr, fq, lds, wid, lane); S.done(cur); }
#undef PG8_SA
#undef PG8_SB
#undef PG8_STAGE
#undef PG8_LDA
#undef PG8_LDB
#undef PG8_MMA
#undef PG8_WAIT_V
#undef PG8_ZERO
#undef PG8_WAIT_L
#undef PG8_BAR
#undef PG8_SCHED
}
}
#define GAS __attribute__((address_space(1)))
#define LAS __attribute__((address_space(3)))
typedef unsigned short bf16;
typedef unsigned v4u __attribute__((ext_vector_type(4)));
typedef float f32x4 __attribute__((ext_vector_type(4)));
typedef short bf16x8 __attribute__((ext_vector_type(8)));
typedef GAS unsigned gu32;
typedef GAS unsigned long long gu64;
#define RLX_AGENT __ATOMIC_RELAXED, __HIP_MEMORY_SCOPE_AGENT
#define LDS_WAIT() asm volatile("s_waitcnt lgkmcnt(0)" ::: "memory")
#define VM_WAIT() asm volatile("s_waitcnt vmcnt(0)" ::: "memory")
__device__ __forceinline__ unsigned long long rt() { return __builtin_amdgcn_s_memrealtime(); }
__device__ __forceinline__ unsigned f2bf(float f) { unsigned u = __builtin_bit_cast(unsigned, f); return (u + 0x7fffu + ((u >> 16) & 1u)) >> 16; }
__device__ __forceinline__ unsigned pk2(float lo, float hi) { return f2bf(lo) | (f2bf(hi) << 16); }

#define XB_TMO      128
#define XB_XCNT(j)  (256  + 64 * (j))
#define XB_XSUB(j)  (1280 + 64 * (j))
#define XB_XGEN(j)  (2304 + 64 * (j))
#define XB_TOP      3328
#define XB_TOPGEN   3392
#define XCD_BAR_WORDS 3456
#define XB_SPIN_CAP (1u << 18)

__device__ __forceinline__ unsigned xb_ld(unsigned* p)              { return __hip_atomic_load(p, __ATOMIC_RELAXED, __HIP_MEMORY_SCOPE_AGENT); }
__device__ __forceinline__ unsigned xb_add(unsigned* p, unsigned v) { return __hip_atomic_fetch_add(p, v, __ATOMIC_RELAXED, __HIP_MEMORY_SCOPE_AGENT); }
__device__ __forceinline__ unsigned xb_xcc_id() { return (unsigned)__builtin_amdgcn_s_getreg((3 << 11) | 20) & 0xFu; }
#define XB_SPIN(cond, bar) do { unsigned _sp = 0; while (cond) { __builtin_amdgcn_s_sleep(1); \
    if ((++_sp & 255u) == 0u) { if (xb_ld(&(bar)[XB_TMO])) break; if (_sp > XB_SPIN_CAP) { atomicAdd(&(bar)[XB_TMO], 1u); break; } } } } while (0)

struct XcdBarrier {
    unsigned* bar; unsigned x;
    volatile LAS unsigned* st;
};

__device__ __forceinline__ XcdBarrier xcd_barrier_post(unsigned* bar, volatile LAS unsigned* st) {
    XcdBarrier b; b.bar = bar; b.x = xb_xcc_id(); b.st = st;
    if (threadIdx.x == 0) (void)xb_add(&bar[XB_XCNT(b.x)], 1u);
    return b;
}
__device__ __forceinline__ void xcd_barrier_complete(unsigned* bar, unsigned x, unsigned& nloc, unsigned& nx) {
    const unsigned G = gridDim.x * gridDim.y * gridDim.z;
    unsigned sum, cnt, mine, sp = 0u;
    for (;;) {
        sum = 0u; cnt = 0u; mine = 0u;
#pragma unroll
        for (unsigned j = 0; j < 16; ++j) { const unsigned c = xb_ld(&bar[XB_XCNT(j)]); sum += c; cnt += (c > 0u) ? 1u : 0u; mine = (j == x) ? c : mine; }
        if (sum == G) break;
        __builtin_amdgcn_s_sleep(1);
        if ((++sp & 255u) == 0u) { if (xb_ld(&bar[XB_TMO])) break; if (sp > XB_SPIN_CAP) { atomicAdd(&bar[XB_TMO], 1u); break; } }
    }
    nloc = mine > 0u ? mine : 1u; nx = cnt > 0u ? cnt : 1u;
}

__device__ __forceinline__ void xcd_barrier(const XcdBarrier& b) {
    asm volatile("s_waitcnt vmcnt(0)" ::: "memory");
    __syncthreads();
    if (threadIdx.x == 0) {
        unsigned* bar = b.bar;
        __builtin_amdgcn_s_waitcnt(0);
        unsigned nloc = b.st[0], nx = b.st[1];
        if (nloc == 0u) { xcd_barrier_complete(bar, b.x, nloc, nx); b.st[0] = nloc; b.st[1] = nx; }
        const unsigned old = xb_add(&bar[XB_XSUB(b.x)], 1u);
        const unsigned gen = old / nloc;
        if (old + 1u == (gen + 1u) * nloc) {
            __builtin_amdgcn_fence(__ATOMIC_RELEASE, "agent");
            asm volatile("s_waitcnt vmcnt(0)" ::: "memory");
            const unsigned og = xb_add(&bar[XB_TOP], 1u);
            const unsigned tg = og / nx;
            if (og + 1u == (tg + 1u) * nx) xb_add(&bar[XB_TOPGEN], 1u);
            else XB_SPIN(xb_ld(&bar[XB_TOPGEN]) == tg, bar);
            __builtin_amdgcn_fence(__ATOMIC_ACQUIRE, "agent");
            xb_add(&bar[XB_XGEN(b.x)], 1u);
            asm volatile("s_waitcnt vmcnt(0)" ::: "memory");
        } else {
            XB_SPIN(xb_ld(&bar[XB_XGEN(b.x)]) == gen, bar);
            __builtin_amdgcn_fence(__ATOMIC_ACQUIRE, "agent");
            asm volatile("s_waitcnt vmcnt(0)" ::: "memory");
        }
    }
    __syncthreads();
}
using pg8::bf_lo; using pg8::bf_hi;
constexpr int DM = 1024, MP = 8 * 4096, MS = 32 * 16, MT = MP + MS;
constexpr int DFF = 2816, DIN = 3584, MMEM = 8 * 256, NKV = 40;
constexpr size_t OFF_Y = 0, OFF_POOLP = (size_t)MT * DM, OFF_POOLS = OFF_POOLP + 8 * 15 * 512, OFF_SGUV = OFF_POOLS + 32 * 15 * 512,
                 OFF_MK = OFF_SGUV + 32 * 16 * 512, OFF_MV = OFF_MK + (size_t)MMEM * DM, OUT_TOTAL = OFF_MV + (size_t)MMEM * DM;
constexpr int NWAVES = 8;
#ifndef MK_PER_PHASE
#define MK_PER_PHASE 0
#endif
constexpr int N_PHASES = 15;

constexpr size_t al256(size_t x) { return (x + 255) & ~(size_t)255; }
constexpr size_t WS_CTL = 0, CTL_ZERO_BYTES = 1u << 20;
constexpr size_t WS_W13A = CTL_ZERO_BYTES;
constexpr size_t WS_W2A  = WS_W13A + al256((size_t)2 * DFF * DM * 2);
constexpr size_t WS_WIN  = WS_W2A  + al256((size_t)DM * DFF * 2);
constexpr size_t WS_WA   = WS_WIN  + al256((size_t)DIN * DM * 2);
constexpr size_t WS_WPB  = WS_WA   + al256((size_t)DM * 512 * 2);
constexpr size_t WS_WO   = WS_WPB  + al256((size_t)DM * 512 * 2);
constexpr size_t WS_WMKV = WS_WO   + al256((size_t)DM * DM * 2);
constexpr size_t WS_WQ   = WS_WMKV + al256((size_t)2 * DM * DM * 2);
constexpr size_t WS_WCO  = WS_WQ   + al256((size_t)DM * DM * 2);
constexpr size_t WS_W13B = WS_WCO  + al256((size_t)DM * DM * 2);
constexpr size_t WS_W2B  = WS_W13B + al256((size_t)2 * DFF * DM * 2);
constexpr size_t WS_WSP  = WS_W2B  + al256((size_t)DM * DFF * 2);
constexpr size_t WS_WSS  = WS_WSP  + al256((size_t)4 * 128 * 128 * 2);
constexpr size_t WS_HB   = WS_WSS  + al256((size_t)4 * 128 * 128 * 2);
constexpr size_t WS_MEMN = WS_HB   + al256((size_t)MT * DM * 2);
constexpr size_t WS_KB   = WS_MEMN + al256((size_t)MMEM * DM * 2);
constexpr size_t WS_VT   = WS_KB   + al256((size_t)NKV * 256 * DM * 2);
constexpr size_t WS_ST0  = WS_VT   + al256((size_t)NKV * 256 * DM * 2);
constexpr size_t WS_ST1  = WS_ST0  + al256((size_t)MT * 64);
constexpr size_t WS_ST2  = WS_ST1  + al256((size_t)MT * 64);
constexpr size_t WS_ST3  = WS_ST2  + al256((size_t)MT * 64);
constexpr size_t WS_STV  = WS_ST3  + al256((size_t)MT * 64);
constexpr size_t WS_RACT = WS_STV  + al256((size_t)MT * 64);
constexpr size_t WS_GATE = WS_RACT, WS_DD = WS_GATE + (size_t)MT * 2048 * 2;
constexpr size_t WS_RZ   = WS_RACT + al256((size_t)MT * DFF * 2);
constexpr size_t WS_XA = WS_RZ, WS_UU = WS_XA + (size_t)MT * 512 * 2, WS_VV = WS_UU + (size_t)MT * 512 * 2, WS_US = WS_VV + (size_t)MT * 512 * 2;
constexpr size_t WS_MRG = WS_RZ, WS_QB = WS_RZ, WS_OB = WS_RZ + (size_t)MT * DM * 2;
constexpr size_t WS_END = WS_RZ + al256((size_t)MT * 2048 * 2);
static_assert(WS_DD + (size_t)MT * 512 * 2 <= WS_RZ, "gate | dd fit in the act region");
static_assert(WS_END <= (size_t)512 * 1024 * 1024, "d_ws map fits 512 MiB");
constexpr int CW_BAR = 4096, CW_XCC = 8192, CW_Q1 = 12288, CW_Q2 = 12352, CW_QF = 12416  , CW_DEP = 16384;
static_assert((CW_DEP + 8 * 136 * 64) * 4 <= (int)CTL_ZERO_BYTES, "CTL words inside the memset region");

constexpr int RING_BYTES = 131072, LDS_BYTES = 163840, LDSCTL_OFF = LDS_BYTES - 1024, MISC_OFF = LDSCTL_OFF + 320;

__device__ __forceinline__ float wave_sum(float v) {
#pragma unroll
    for (int o = 1; o < 64; o <<= 1) v += __shfl_xor(v, o);
    return v;
}
template <bool BLK = true>
__device__ __forceinline__ void transpose_item(const float* W, int ldn, int k0, int n0, const float* gain, bf16* WT, int ldk, int drow0, LAS float* scr, int lane) {
    f32x4 tv[16];
    const int r = lane >> 4, c4 = (lane & 15) * 4;
#pragma unroll
    for (int i = 0; i < 16; ++i) tv[i] = __builtin_nontemporal_load((const f32x4*)(W + (size_t)(k0 + 4 * i + r) * ldn + n0 + c4));
    if (gain) {
#pragma unroll
        for (int i = 0; i < 16; ++i) tv[i] = tv[i] * gain[k0 + 4 * i + r]; }
#pragma unroll
    for (int i = 0; i < 16; ++i) { LAS float* d = scr + (4 * i + r) * 65 + c4; d[0] = tv[i].x; d[1] = tv[i].y; d[2] = tv[i].z; d[3] = tv[i].w; }
    LDS_WAIT(); asm volatile("" ::: "memory");
    const int c = lane & 7;
#pragma unroll
    for (int j = 0; j < 8; ++j) { const int n = (lane >> 3) + 8 * j; const LAS float* sp = scr + (8 * c) * 65 + n;
        v4u o; o.x = pk2(sp[0 * 65], sp[1 * 65]); o.y = pk2(sp[2 * 65], sp[3 * 65]); o.z = pk2(sp[4 * 65], sp[5 * 65]); o.w = pk2(sp[6 * 65], sp[7 * 65]);
        const int drow = drow0 + n;
        bf16* dp = BLK ? (bf16*)((unsigned char*)WT + (size_t)((drow >> 8) * (ldk >> 6) + (k0 >> 6)) * 32768 + pg8::img_off_w(drow & 255, 8 * c)) : WT + (size_t)drow * ldk + k0 + 8 * c;
        *(v4u*)dp = o; }
    LDS_WAIT(); asm volatile("" ::: "memory");
}
constexpr int TR_SCR_BYTES = 64 * 65 * 4;

struct Args { const float* in[32]; float* out; unsigned char* ws; int ph_lo, ph_hi; };

template <int PART>
__device__ __forceinline__ void phase_prep(const Args& A, LAS unsigned char* lds, int tid, int wave, int lane, int wgi, int nwg, unsigned* queue) {
    unsigned char* ws = A.ws;
    LAS float* scr = (LAS float*)(lds + wave * TR_SCR_BYTES);
    const int gw = wgi * NWAVES + wave, NGW = nwg * NWAVES;
    for (int pass = 0; pass < (PART == 0 ? 2 : 1); ++pass) {
    const bool do_ab = (PART != 0) || ((pass == 0) == ((wave & 1) == 0));
    if (do_ab) {
    constexpr int I_W1 = (DM / 64) * (DFF / 64), I_W2 = (DFF / 64) * (DM / 64), I_PB = (512 / 64) * (DM / 64), I_SQ = (DM / 64) * (DM / 64), I_VT = 32 * (256 / 64) * (DM / 64);
    constexpr int I_WINA = (DM / 64) * 24, I_WINB = (DM / 64) * 32;
    constexpr int VT1 = 23 * 64, VT2 = I_VT - VT1, I_PVT = 8 * 64;
    constexpr int NITEMS = PART == 0 ? 2 * I_W1 + I_W2 + I_WINA + 2 * I_SQ : (PART == 1 ? I_PB + 2 * I_SQ + I_WINB + VT1 : VT2 + I_PVT + 2 * I_W1 + I_W2 + I_SQ);
    constexpr int ROW0 = PART == 0 ? 0 : MT + MMEM, NROWS = PART == 0 ? MT + MMEM : (PART == 1 ? MT + MMEM : MT + MMEM + 32 * 256);
    constexpr int NWORK = NITEMS + (NROWS - ROW0) / 4;
    static_assert(MP % 4 == 0 && MT % 4 == 0 && MMEM % 4 == 0, "row items must not straddle kinds");
    const bool dyn = queue != nullptr;
    volatile LAS unsigned* qslot = (volatile LAS unsigned*)(lds + MISC_OFF) + 16;
    unsigned nextq = 0; if (dyn && tid == 0) nextq = __hip_atomic_fetch_add(queue, (unsigned)NWAVES, RLX_AGENT);
    int w = gw;
    for (;;) {
        if (dyn) { if (tid == 0) *qslot = nextq; __syncthreads(); const int base = (int)*qslot; __syncthreads(); if (base >= NWORK) break;
            if (tid == 0) nextq = __hip_atomic_fetch_add(queue, (unsigned)NWAVES, RLX_AGENT); w = base + wave; }
        if (w >= NWORK) { if (dyn) continue; else break; }
        if (w < NITEMS) {
        int r = w;
        do {
#define W13_ITEM(SRC, GAIN, DST, HALFSEL) if (r < I_W1) { const int nblk = DFF / 64, kb = r / nblk, nb = r % nblk, n0 = 64 * nb; \
            transpose_item(SRC, DFF, 64 * kb, n0, GAIN, (bf16*)(ws + DST), DM, (n0 >> 7) * 256 + HALFSEL * 128 + (n0 & 127), scr, lane); break; } r -= I_W1;
#define PLAIN_ITEM(SRC, KK, NN, GAIN, DST, ROWOFF, CNT) if (r < CNT) { const int nblk = NN / 64, kb = r / nblk, nb = r % nblk; \
            transpose_item(SRC, NN, 64 * kb, 64 * nb, GAIN, (bf16*)(ws + DST), KK, ROWOFF + 64 * nb, scr, lane); break; } r -= CNT;
#define VT_ITEM(FIRST, CNT) if (r < CNT) { const int q = r + FIRST, b = q / 64, rr = q % 64, kb = rr / 16, nb = rr % 16; \
            transpose_item<false>(A.in[4] + (size_t)b * 256 * DM, DM, 64 * kb, 64 * nb, nullptr, (bf16*)(ws + WS_VT) + (size_t)(8 + b) * DM * 256, 256, 64 * nb, scr, lane); break; } r -= CNT;
#define WIN_ITEM(NB0, NBC, CNT) if (r < CNT) { const int kb = r / NBC, nb = NB0 + r % NBC; \
            transpose_item(A.in[11], DIN, 64 * kb, 64 * nb, A.in[10], (bf16*)(ws + WS_WIN), DM, 64 * nb, scr, lane); break; } r -= CNT;
#define PVT_ITEM() if (r < I_PVT) { const int b = r / 64, rr = r % 64, kb = rr / 16, nb = rr % 16; \
            transpose_item<false>(A.out + OFF_MV + (size_t)b * 256 * DM, DM, 64 * kb, 64 * nb, nullptr, (bf16*)(ws + WS_VT) + (size_t)b * DM * 256, 256, 64 * nb, scr, lane); break; } r -= I_PVT;
        if constexpr (PART == 0) {
            W13_ITEM(A.in[7], A.in[6], WS_W13A, 0)
            W13_ITEM(A.in[8], A.in[6], WS_W13A, 1)
            PLAIN_ITEM(A.in[9], DFF, DM, nullptr, WS_W2A, 0, I_W2)
            WIN_ITEM(0, 24, I_WINA)
            PLAIN_ITEM(A.in[22], DM, DM, nullptr, WS_WMKV, 0, I_SQ)
            PLAIN_ITEM(A.in[23], DM, DM, nullptr, WS_WMKV, 1024, I_SQ)
        } else if constexpr (PART == 1) {
            PLAIN_ITEM(A.in[19], 512, DM, nullptr, WS_WPB, 0, I_PB)
            PLAIN_ITEM(A.in[20], DM, DM, nullptr, WS_WO, 0, I_SQ)
            PLAIN_ITEM(A.in[25], DM, DM, A.in[24], WS_WQ, 0, I_SQ)
            WIN_ITEM(24, 32, I_WINB)
            VT_ITEM(0, VT1)
        } else {
            VT_ITEM(VT1, VT2)
            PVT_ITEM()
            W13_ITEM(A.in[28], A.in[27], WS_W13B, 0)
            W13_ITEM(A.in[29], A.in[27], WS_W13B, 1)
            PLAIN_ITEM(A.in[30], DFF, DM, nullptr, WS_W2B, 0, I_W2)
            PLAIN_ITEM(A.in[26], DM, DM, nullptr, WS_WCO, 0, I_SQ)
        }
#undef W13_ITEM
#undef PLAIN_ITEM
#undef VT_ITEM
#undef WIN_ITEM
#undef PVT_ITEM
        } while (false);
        } else if constexpr (PART != 1) {
            const int r0 = ROW0 + 4 * (w - NITEMS);
            int kind; const float* src; bf16* dst;
            if (r0 < MT) { kind = 0; src = (r0 < MP) ? A.in[0] + (size_t)r0 * DM : A.in[1] + (size_t)(r0 - MP) * DM; dst = (bf16*)(ws + WS_HB) + (size_t)r0 * DM; }
            else if (r0 < MT + MMEM) { kind = 1; src = A.in[5] + (size_t)(r0 - MT) * DM; dst = (bf16*)(ws + WS_MEMN) + (size_t)(r0 - MT) * DM; }
            else { kind = 2; src = A.in[3] + (size_t)(r0 - MT - MMEM) * DM; dst = (bf16*)(ws + WS_KB) + (size_t)(8 * 256 + (r0 - MT - MMEM)) * DM; }
            f32x4 v[4][4];
#pragma unroll
            for (int h = 0; h < 4; ++h)
#pragma unroll
                for (int j = 0; j < 4; ++j) v[h][j] = __builtin_nontemporal_load((const f32x4*)(src + (size_t)h * DM) + lane + 64 * j);
#pragma unroll
            for (int h = 0; h < 4; ++h) { const int rr = r0 + h;
                float s = 0.f;
#pragma unroll
                for (int j = 0; j < 4; ++j) s += (v[h][j].x * v[h][j].x + v[h][j].y * v[h][j].y) + (v[h][j].z * v[h][j].z + v[h][j].w * v[h][j].w);
                if (kind != 2) s = wave_sum(s);
                if (kind == 0) { float* st = (float*)(ws + WS_ST0) + (size_t)rr * 16; if (lane < 16) st[lane] = (lane == 0) ? s : 0.f; }
                if (kind == 1) { const float rin = 1.0f / sqrtf(s * (1.0f / DM) + 1e-6f); const f32x4* gr = (const f32x4*)A.in[21] + lane;
#pragma unroll
                    for (int j = 0; j < 4; ++j) v[h][j] = v[h][j] * rin * gr[64 * j]; }
                unsigned long long* o8 = (unsigned long long*)(dst + (size_t)h * DM) + lane;
#pragma unroll
                for (int j = 0; j < 4; ++j) { const unsigned long long ov = (unsigned long long)pk2(v[h][j].x, v[h][j].y) | ((unsigned long long)pk2(v[h][j].z, v[h][j].w) << 32);
                    if (kind == 0) *(unsigned long long*)(ws + WS_HB + pg8::hb_byte(rr, 4 * (lane + 64 * j))) = ov;
                    else if (kind == 1) *(unsigned long long*)(ws + WS_MEMN + pg8::hb_byte(rr - MT, 4 * (lane + 64 * j))) = ov;
                    else { const int kr = 8 * 256 + (rr - MT - MMEM);
                        *(unsigned long long*)((bf16*)(ws + WS_KB) + ((size_t)((kr >> 8) * 4 + j) * 256 + (kr & 255)) * 256 + 4 * lane) = ov; } } }
        }
        if (!dyn) w += NGW;
    }
    } else {
    if constexpr (PART == 0) {
    const int gt = wgi * (NWAVES * 64) + tid, NGT = nwg * NWAVES * 64;
    for (int idx = gt; idx < 512 * 256; idx += NGT) {
        const int k = idx >> 8, n4 = (idx & 255) * 4, g = k >> 7;
        const float* wp = A.in[13] + (size_t)k * 128; const float* ps = A.in[14] + g * 128; const float* pa = A.in[18] + (size_t)(g * 128) * DM + n4;
        f32x4 acc = (f32x4){0.f, 0.f, 0.f, 0.f};
#pragma unroll 16
        for (int d = 0; d < 128; ++d) { const float c = wp[d] * ps[d]; acc += *(const f32x4*)(pa + (size_t)d * DM) * c; }
        unsigned char* ob = ws + WS_WA + (size_t)((n4 >> 8) * 8 + (k >> 6)) * 32768;
        *(bf16*)(ob + pg8::img_off_w((n4 & 255) + 0, k & 63)) = (bf16)f2bf(acc.x); *(bf16*)(ob + pg8::img_off_w((n4 & 255) + 1, k & 63)) = (bf16)f2bf(acc.y);
        *(bf16*)(ob + pg8::img_off_w((n4 & 255) + 2, k & 63)) = (bf16)f2bf(acc.z); *(bf16*)(ob + pg8::img_off_w((n4 & 255) + 3, k & 63)) = (bf16)f2bf(acc.w);
    }
    for (int idx = gt; idx < 2 * 65536; idx += NGT) {
        const int smp = idx >> 16, h = (idx >> 14) & 3, p = (idx >> 7) & 127, q = idx & 127;
        float w;
        if (!smp) w = ((p >> 6) >= (q >> 6)) ? A.in[16][(size_t)(h * 128 + p) * 128 + q] : 0.f;
        else w = ((p >> 4) == (q >> 4)) ? A.in[16][(size_t)(h * 128 + (p & 15)) * 128 + (q & 15)] : 0.f;
        ((bf16*)(ws + (smp ? WS_WSS : WS_WSP)))[(size_t)(h * 128 + p) * 128 + q] = (bf16)f2bf(w);
    }
    }
    }
    }
}

__device__ __forceinline__ void phase_mixprep(const Args& A, LAS unsigned char* lds, int tid, int wave, int lane, int vcu, int G) {
    unsigned char* ws = A.ws;
    const int gw = vcu * NWAVES + wave, NGW = G * NWAVES;
    {
        const bf16* xa = (const bf16*)(ws + WS_XA); bf16* dd = (bf16*)(ws + WS_DD);
        const int cg = lane, w = 2 << (cg >> 4);
        const int pgw = (G == 256) ? (vcu >= 16 ? (vcu - 16) * NWAVES + wave : MT) : gw, pngw = (G == 256) ? 240 * NWAVES : NGW;
        for (int rr = pgw; rr < MT / 16; rr += pngw) {
            const int row0 = rr * 16; const bool smp = row0 >= MP;
            const int t0 = smp ? 0 : (row0 & 4095);
            const bf16* xp = xa + (size_t)row0 * 512 + cg * 8;
            v4u X[31];
#pragma unroll
            for (int i = 0; i < 16; ++i) X[15 + i] = *(const v4u*)(xp + i * 512);
            if (smp) {
                const float* stp = A.in[2] + (size_t)((row0 - MP) >> 4) * 15 * 512 + cg * 8;
#pragma unroll
                for (int j = 1; j < 16; ++j) { const f32x4 a = *(const f32x4*)(stp + (15 - j) * 512), b = *(const f32x4*)(stp + (15 - j) * 512 + 4);
                    v4u p; p.x = pk2(a.x, a.y); p.y = pk2(a.z, a.w); p.z = pk2(b.x, b.y); p.w = pk2(b.z, b.w); X[15 - j] = p; }
            } else {
#pragma unroll
                for (int j = 1; j < 16; ++j) { const bool ok = t0 - j >= 0; const v4u x = *(const v4u*)(xp - (ok ? j : 0) * 512); X[15 - j] = ok ? x : (v4u){0u, 0u, 0u, 0u}; }
            }
            float s[8];
#pragma unroll
            for (int j = 0; j < 8; ++j) s[j] = 0.f;
#pragma unroll
            for (int j = 1; j < 16; ++j) { const float mk = (j < w) ? 1.0f : 0.0f; const v4u x = X[15 - j];
                s[0] += mk * bf_lo(x.x); s[1] += mk * bf_hi(x.x); s[2] += mk * bf_lo(x.y); s[3] += mk * bf_hi(x.y); s[4] += mk * bf_lo(x.z); s[5] += mk * bf_hi(x.z); s[6] += mk * bf_lo(x.w); s[7] += mk * bf_hi(x.w); }
#pragma unroll
            for (int i = 0; i < 16; ++i) {
                const v4u x = X[15 + i];
                s[0] += bf_lo(x.x); s[1] += bf_hi(x.x); s[2] += bf_lo(x.y); s[3] += bf_hi(x.y); s[4] += bf_lo(x.z); s[5] += bf_hi(x.z); s[6] += bf_lo(x.w); s[7] += bf_hi(x.w);
                const int nv = smp ? w : ((t0 + i + 1 < w) ? t0 + i + 1 : w);
                const float ic = 1.0f / (float)nv;
                v4u o; o.x = pk2(s[0] * ic - bf_lo(x.x), s[1] * ic - bf_hi(x.x)); o.y = pk2(s[2] * ic - bf_lo(x.y), s[3] * ic - bf_hi(x.y)); o.z = pk2(s[4] * ic - bf_lo(x.z), s[5] * ic - bf_hi(x.z)); o.w = pk2(s[6] * ic - bf_lo(x.w), s[7] * ic - bf_hi(x.w));
                *(v4u*)((unsigned char*)dd + pg8::k512_byte(row0 + i, cg * 8)) = o;
                const v4u y2 = X[14 + i], y4 = X[12 + i], y8 = X[8 + i], y16 = X[i];
                v4u y; y.x = (w == 2) ? y2.x : (w == 4) ? y4.x : (w == 8) ? y8.x : y16.x; y.y = (w == 2) ? y2.y : (w == 4) ? y4.y : (w == 8) ? y8.y : y16.y;
                y.z = (w == 2) ? y2.z : (w == 4) ? y4.z : (w == 8) ? y8.z : y16.z; y.w = (w == 2) ? y2.w : (w == 4) ? y4.w : (w == 8) ? y8.w : y16.w;
                s[0] -= bf_lo(y.x); s[1] -= bf_hi(y.x); s[2] -= bf_lo(y.y); s[3] -= bf_hi(y.y); s[4] -= bf_lo(y.z); s[5] -= bf_hi(y.z); s[6] -= bf_lo(y.w); s[7] -= bf_hi(y.w);
            }
        }
    }
    __syncthreads();
    {
        const bf16* vv = (const bf16*)(ws + WS_VV); const bf16* uu = (const bf16*)(ws + WS_UU); bf16* us = (bf16*)(ws + WS_US);
        const float* stv = (const float*)(ws + WS_STV);
        LAS bf16* VT = (LAS bf16*)lds;
        const int fr = lane & 15, fq = lane >> 4;
        for (int un = vcu; un < (MT / 128) * 4; un += G) {
            const int ci = un >> 2, hd = un & 3, row0 = ci * 128; const bool smp = row0 >= MP;
            const bf16* wsel = (const bf16*)(ws + (smp ? WS_WSS : WS_WSP)) + (size_t)hd * 128 * 128;
            const int p = wave * 16 + fr, prow = row0 + p;
            bf16x8 wf[4];
#pragma unroll
            for (int ks = 0; ks < 4; ++ks) wf[ks] = *(const bf16x8*)(wsel + (size_t)p * 128 + ks * 32 + 8 * fq);
            unsigned long long ur[8];
#pragma unroll
            for (int nt = 0; nt < 8; ++nt) ur[nt] = __builtin_nontemporal_load((const unsigned long long*)(uu + (size_t)prow * 512 + hd * 128 + nt * 16 + 4 * fq));
            const f32x4 g0 = *(const f32x4*)(A.in[15] + hd * 128 + (tid & 15) * 8), g1 = *(const f32x4*)(A.in[15] + hd * 128 + (tid & 15) * 8 + 4);
#pragma unroll
            for (int it = 0; it < 4; ++it) {
                const int idx = it * 512 + tid, q = idx >> 4, c8 = idx & 15, row = row0 + q;
                const v4u raw = __builtin_nontemporal_load((const v4u*)(vv + (size_t)row * 512 + hd * 128 + c8 * 8));
                const f32x4* sp = (const f32x4*)(stv + (size_t)row * 16); const f32x4 a = sp[0], b = sp[1], c = sp[2], d = sp[3];
                const float sum = ((a.x + a.z) + (b.x + b.z)) + ((c.x + c.z) + (d.x + d.z)), sq = ((a.y + a.w) + (b.y + b.w)) + ((c.y + c.w) + (d.y + d.w));
                const float mu = sum * (1.0f / 512.0f); float var = sq * (1.0f / 512.0f) - mu * mu; var = var > 0.f ? var : 0.f;
                const float rs = 1.0f / sqrtf(var + 1e-6f);
                float x[8];
                x[0] = (bf_lo(raw.x) - mu) * rs * g0.x; x[1] = (bf_hi(raw.x) - mu) * rs * g0.y; x[2] = (bf_lo(raw.y) - mu) * rs * g0.z; x[3] = (bf_hi(raw.y) - mu) * rs * g0.w;
                x[4] = (bf_lo(raw.z) - mu) * rs * g1.x; x[5] = (bf_hi(raw.z) - mu) * rs * g1.y; x[6] = (bf_lo(raw.w) - mu) * rs * g1.z; x[7] = (bf_hi(raw.w) - mu) * rs * g1.w;
                if (smp) { float* dst = A.out + OFF_SGUV + (size_t)(row - MP) * 512 + hd * 128 + c8 * 8; *(f32x4*)dst = (f32x4){x[0], x[1], x[2], x[3]}; *(f32x4*)(dst + 4) = (f32x4){x[4], x[5], x[6], x[7]}; }
#pragma unroll
                for (int j = 0; j < 8; ++j) VT[(c8 * 8 + j) * 136 + ((((q >> 3) ^ c8) << 3) | (q & 7))] = (bf16)f2bf(x[j]);
            }
            __syncthreads();
            f32x4 acc[8];
#pragma unroll
            for (int nt = 0; nt < 8; ++nt) acc[nt] = (f32x4){0.f, 0.f, 0.f, 0.f};
#pragma unroll
            for (int ks = 0; ks < 4; ++ks) {
#pragma unroll
                for (int nt = 0; nt < 8; ++nt) { const bf16x8 vf = *(const LAS bf16x8*)(VT + (nt * 16 + fr) * 136 + (((ks * 4 + fq) ^ (nt * 2 + (fr >> 3))) << 3));
                    acc[nt] = __builtin_amdgcn_mfma_f32_16x16x32_bf16(vf, wf[ks], acc[nt], 0, 0, 0); }
            }
            const float bias = A.in[17][hd * 128 + (smp ? fr : p)];
#pragma unroll
            for (int nt = 0; nt < 8; ++nt) { const int col = hd * 128 + nt * 16 + 4 * fq;
                const unsigned u0 = (unsigned)ur[nt], u1 = (unsigned)(ur[nt] >> 32);
                const float o0 = bf_lo(u0) * (acc[nt].x + bias), o1 = bf_hi(u0) * (acc[nt].y + bias), o2 = bf_lo(u1) * (acc[nt].z + bias), o3 = bf_hi(u1) * (acc[nt].w + bias);
                *(unsigned long long*)((unsigned char*)us + pg8::k512_byte(prow, col)) = (unsigned long long)pk2(o0, o1) | ((unsigned long long)pk2(o2, o3) << 32); }
            __syncthreads();
        }
    }
}

__device__ __forceinline__ void glds16_asm(const void* gsrc, unsigned lds_dst) {
    unsigned keep;
    asm volatile("s_mov_b32 %0, m0\n\ts_mov_b32 m0, %2\n\ts_nop 0\n\tglobal_load_lds_dwordx4 %1, off\n\ts_mov_b32 m0, %0" : "=&s"(keep) : "v"(gsrc), "s"(lds_dst) : "memory");
}
constexpr int ATT_NBUF = 5, ATT_CHB = 16384, ATT_P_OFF = ATT_NBUF * ATT_CHB, ATT_P_STRIDE = 8448, ATT_ITEMS = 1024 + 128;
static_assert(ATT_P_OFF + 8 * ATT_P_STRIDE <= LDSCTL_OFF, "attention LDS map");
__device__ __forceinline__ void phase_attention(const Args& A, LAS unsigned char* lds, int tid, int wave, int lane, int vcu, int G) {
    unsigned char* ws = A.ws;
    const bf16* qb = (const bf16*)(ws + WS_QB); const bf16* kb = (const bf16*)(ws + WS_KB); const bf16* vt = (const bf16*)(ws + WS_VT); bf16* ob = (bf16*)(ws + WS_OB);
    LAS bf16* P = (LAS bf16*)(lds + ATT_P_OFF + wave * ATT_P_STRIDE);
    const int fr = lane & 15, fq = lane >> 4;
    int srow[2], scolK[2], scolV[2];
#pragma unroll
    for (int i = 0; i < 2; ++i) { const int p = (wave * 2 + i) * 64 + lane; srow[i] = p >> 5; scolV[i] = ((p & 31) ^ (srow[i] & 15)) * 8; scolK[i] = ((p & 31) ^ ((((srow[i] >> 3) & 3) << 2) | (srow[i] & 3))) * 8; }
    const unsigned lds_base = __builtin_amdgcn_readfirstlane((unsigned)(size_t)lds);
    const int rd_off = fr * 512 + ((fq ^ fr) * 16);
    const int rdk_off = (8 * (fr >> 2) + (fr & 3)) * 512 + ((fq ^ fr) * 16);
    for (int it0 = vcu; it0 < ATT_ITEMS; it0 += G) {
        int it = it0;
        if (G == 256 && it0 < 1024) { const int rnd = it0 >> 8, pair = (vcu >> 5) * 4 + ((vcu >> 3) & 3); it = pair * 32 + (vcu & 7) + 8 * rnd; }
        int kvb, hd, rbase, nact;
        if (it < 1024) { kvb = it >> 7; hd = (it >> 5) & 3; rbase = kvb * 4096 + (it & 31) * 128; nact = 8; }
        else { const int t = it - 1024; kvb = 8 + (t >> 2); hd = t & 3; rbase = MP + (t >> 2) * 16; nact = 1; }
        const bool active = wave < nact;
        const int r0 = rbase + (active ? wave : 0) * 16;
        const bf16* gp[2];
#pragma unroll
        for (int i = 0; i < 2; ++i) gp[i] = kb + (size_t)(kvb * 4 + hd) * 65536 + (size_t)srow[i] * 256 + scolK[i];
        const bf16* vsrc = vt + ((size_t)kvb * DM + hd * 256) * 256;
#define ATT_ISSUE(c) do { const unsigned dstb = lds_base + ((c) % ATT_NBUF) * ATT_CHB + wave * 2048; \
            _Pragma("unroll") for (int i = 0; i < 2; ++i) { if ((c) == 8) gp[i] = vsrc + (size_t)srow[i] * 256 + scolV[i]; \
                glds16_asm(gp[i], dstb + i * 1024); \
                gp[i] += 32 * 256; asm volatile("" : "+v"(gp[i])); } } while (0)
#define ATT_BOUNDARY(b) do { if ((b) <= 12) asm volatile("s_waitcnt vmcnt(6)" ::: "memory"); else if ((b) == 13) asm volatile("s_waitcnt vmcnt(4)" ::: "memory"); \
            else if ((b) == 14) asm volatile("s_waitcnt vmcnt(2)" ::: "memory"); else asm volatile("s_waitcnt vmcnt(0)" ::: "memory"); \
            asm volatile("s_waitcnt lgkmcnt(0)" ::: "memory"); __builtin_amdgcn_s_barrier(); asm volatile("" ::: "memory"); \
            if ((b) + 4 < 16) ATT_ISSUE((b) + 4); } while (0)
#define ATT_LOAD(dst, c, h) do { const LAS unsigned char* _b = lds + ((c) % ATT_NBUF) * ATT_CHB + (((c) < 8) ? (h) * 2048 + rdk_off : (h) * 8192 + rd_off); \
            _Pragma("unroll") for (int ks = 0; ks < 8; ++ks) dst[ks] = *(const LAS bf16x8*)(_b + ((((c) < 8) ? rdk_off : rd_off) ^ (ks * 64)) - (((c) < 8) ? rdk_off : rd_off)); } while (0)
        ATT_ISSUE(0); ATT_ISSUE(1); ATT_ISSUE(2); ATT_ISSUE(3);
        bf16x8 qf[8];
        {
#pragma unroll
            for (int ks = 0; ks < 8; ++ks) qf[ks] = __builtin_nontemporal_load((const bf16x8*)((const unsigned char*)qb + pg8::hb_byte(r0 + fr, hd * 256 + ks * 32 + 8 * fq)));
#pragma unroll
            for (int ks = 0; ks < 8; ++ks) asm volatile("" : "+v"(qf[ks])); }
        f32x4 s[16];
#pragma unroll
        for (int nt = 0; nt < 16; ++nt) s[nt] = (f32x4){0.f, 0.f, 0.f, 0.f};
        if (!active) {
            ATT_BOUNDARY(0);
#pragma unroll
            for (int c = 0; c < 15; ++c) ATT_BOUNDARY(c + 1);
        } else {
        bf16x8 fa[8], fb[8]; float inv = 0.f;
        ATT_BOUNDARY(0);
        ATT_LOAD(fa, 0, 0);
#pragma unroll
        for (int c = 0; c < 16; ++c) {
            ATT_LOAD(fb, c, 1);
            __builtin_amdgcn_sched_barrier(0);
            if (c < 8) {
#pragma unroll
                for (int ks = 0; ks < 8; ++ks) s[c * 2] = __builtin_amdgcn_mfma_f32_16x16x32_bf16(fa[ks], qf[ks], s[c * 2], 0, 0, 0);
            } else {
                f32x4 o = (f32x4){0.f, 0.f, 0.f, 0.f};
#pragma unroll
                for (int ks = 0; ks < 8; ++ks) o = __builtin_amdgcn_mfma_f32_16x16x32_bf16(fa[ks], qf[ks], o, 0, 0, 0);
                *(LAS unsigned long long*)(P + fr * 264 + (c - 8) * 32 + 4 * fq) = (unsigned long long)pk2(o.x * inv, o.y * inv) | ((unsigned long long)pk2(o.z * inv, o.w * inv) << 32);
            }
            __builtin_amdgcn_sched_barrier(0);
            if (c < 15) { ATT_BOUNDARY(c + 1); ATT_LOAD(fa, c + 1, 0); }
            __builtin_amdgcn_sched_barrier(0);
            if (c < 8) {
#pragma unroll
                for (int ks = 0; ks < 8; ++ks) s[c * 2 + 1] = __builtin_amdgcn_mfma_f32_16x16x32_bf16(fb[ks], qf[ks], s[c * 2 + 1], 0, 0, 0);
                if (c == 7) {
                    float mx = s[0][0];
#pragma unroll
                    for (int nt = 0; nt < 16; ++nt)
#pragma unroll
                        for (int j = 0; j < 4; ++j) mx = fmaxf(mx, s[nt][j]);
                    mx = fmaxf(mx, __shfl_xor(mx, 16)); mx = fmaxf(mx, __shfl_xor(mx, 32));
                    float sm = 0.f;
#pragma unroll
                    for (int ks = 0; ks < 8; ++ks) { float pe[8];
#pragma unroll
                        for (int h = 0; h < 2; ++h)
#pragma unroll
                            for (int j = 0; j < 4; ++j) { pe[4 * h + j] = __builtin_amdgcn_exp2f(s[2 * ks + h][j] - mx); sm += pe[4 * h + j]; }
                        pg8::u32x4 w; w.x = pg8::cvt_pk_bf16(pe[0], pe[1]); w.y = pg8::cvt_pk_bf16(pe[2], pe[3]); w.z = pg8::cvt_pk_bf16(pe[4], pe[5]); w.w = pg8::cvt_pk_bf16(pe[6], pe[7]);
                        qf[ks] = __builtin_bit_cast(bf16x8, w); }
                    sm += __shfl_xor(sm, 16); sm += __shfl_xor(sm, 32); inv = 1.0f / sm;
                }
            } else {
                f32x4 o = (f32x4){0.f, 0.f, 0.f, 0.f};
#pragma unroll
                for (int ks = 0; ks < 8; ++ks) o = __builtin_amdgcn_mfma_f32_16x16x32_bf16(fb[ks], qf[ks], o, 0, 0, 0);
                *(LAS unsigned long long*)(P + fr * 264 + (c - 8) * 32 + 16 + 4 * fq) = (unsigned long long)pk2(o.x * inv, o.y * inv) | ((unsigned long long)pk2(o.z * inv, o.w * inv) << 32);
            }
            __builtin_amdgcn_sched_barrier(0);
        }
        }
        if (active) { LDS_WAIT(); asm volatile("" ::: "memory"); __builtin_amdgcn_wave_barrier();
#pragma unroll
            for (int t = 0; t < 8; ++t) { const int row = lane >> 2, c4 = lane & 3;
                const v4u w = *(const LAS v4u*)(P + row * 264 + t * 32 + c4 * 8); *(v4u*)((unsigned char*)ob + pg8::hb_byte(r0 + row, hd * 256 + t * 32 + c4 * 8)) = w; } }
        asm volatile("s_waitcnt lgkmcnt(0)" ::: "memory"); __builtin_amdgcn_s_barrier(); asm volatile("" ::: "memory");
#undef ATT_ISSUE
#undef ATT_BOUNDARY
#undef ATT_LOAD
    }
    VM_WAIT(); __syncthreads();
}

__device__ __forceinline__ void wait_panel(const unsigned* dep, int pm, unsigned need, unsigned* tmo) {
    if (threadIdx.x < 64) {
        unsigned polls = 0;
        while ((unsigned)__builtin_amdgcn_readfirstlane(__hip_atomic_load(dep + 64 * pm, RLX_AGENT)) < need) {
            if ((++polls & 1023u) == 0u) { if (__builtin_amdgcn_readfirstlane(__hip_atomic_load(tmo, RLX_AGENT)) != 0u) break;
                if (polls > (1u << 22)) { if (threadIdx.x == 0) __hip_atomic_store(tmo, 1u, RLX_AGENT); break; } }
            __builtin_amdgcn_s_sleep(2); }
        __builtin_amdgcn_fence(__ATOMIC_ACQUIRE, "agent");
        asm volatile("s_waitcnt vmcnt(0)" ::: "memory");
    }
    asm volatile("" ::: "memory"); __builtin_amdgcn_s_barrier(); asm volatile("" ::: "memory");
}
__device__ __forceinline__ void phase_final_q(const Args& A, LAS unsigned char* lds, int tid, int wave, int lane, int bx, unsigned* queues, const unsigned* dep, unsigned* tmo) {
    const bf16* hb = (const bf16*)(A.ws + WS_HB); const float* st = (const float*)(A.ws + WS_ST0);
    f32x4 g0[2], g1[2];
#pragma unroll
    for (int j = 0; j < 2; ++j) { g0[j] = *(const f32x4*)(A.in[31] + 8 * (lane + 64 * j)); g1[j] = *(const f32x4*)(A.in[31] + 8 * (lane + 64 * j) + 4); }
    volatile LAS unsigned* qslot = (volatile LAS unsigned*)(lds + MISC_OFF) + 16;
    int okpm = -1;
    for (int pass = 0; pass < 2; ++pass) {
        unsigned* q = queues + 64 * (pass == 0 ? (bx & 7) : 8);
        const int nround = pass == 0 ? 16 * 8 : 2 * 8, pm0 = pass == 0 ? 16 * (bx & 7) : 128;
        unsigned nextq = 0; if (tid == 0) nextq = __hip_atomic_fetch_add(q, 1u, RLX_AGENT);
        for (;;) {
            if (tid == 0) *qslot = nextq; __syncthreads(); const int rd = (int)*qslot; __syncthreads(); if (rd >= nround) break;
            if (tid == 0) nextq = __hip_atomic_fetch_add(q, 1u, RLX_AGENT);
            const int pm = pm0 + (rd >> 3);
            if (pm != okpm) { wait_panel(dep, pm, 32u, tmo); okpm = pm; }
            const int row0 = pm * 256 + (rd & 7) * 32 + wave * 4;
            v4u h[4][2]; f32x4 pq[4];
#pragma unroll
            for (int k = 0; k < 4; ++k) { const int r = row0 + k;
                pq[k] = *(const f32x4*)(st + (size_t)r * 16 + 4 * (lane & 3));
#pragma unroll
                for (int j = 0; j < 2; ++j) h[k][j] = __builtin_nontemporal_load((const v4u*)((const unsigned char*)hb + pg8::hb_byte(r, 8 * (lane + 64 * j)))); }
#pragma unroll
            for (int k = 0; k < 4; ++k) { const int row = row0 + k;
                float sq = (pq[k].x + pq[k].y) + (pq[k].z + pq[k].w); sq += __shfl_xor(sq, 1); sq += __shfl_xor(sq, 2);
                const float rin = __builtin_amdgcn_rsqf(sq * (1.0f / DM) + 1e-6f);
                float* yr = A.out + OFF_Y + (size_t)row * DM;
#pragma unroll
                for (int j = 0; j < 2; ++j) { const int c = 8 * (lane + 64 * j); const v4u hh = h[k][j];
                    f32x4 a, b; a.x = bf_lo(hh.x); a.y = bf_hi(hh.x); a.z = bf_lo(hh.y); a.w = bf_hi(hh.y); b.x = bf_lo(hh.z); b.y = bf_hi(hh.z); b.z = bf_lo(hh.w); b.w = bf_hi(hh.w);
                    __builtin_nontemporal_store(a * rin * g0[j], (f32x4*)(yr + c)); __builtin_nontemporal_store(b * rin * g1[j], (f32x4*)(yr + c + 4)); } }
        }
    }
}

__global__ void __launch_bounds__(NWAVES * 64, 2) fwd_kernel(Args args) {
    extern __shared__ __attribute__((aligned(16))) unsigned char lds_raw[];
    LAS unsigned char* lds = (LAS unsigned char*)lds_raw;
    volatile LAS unsigned* MISC = (volatile LAS unsigned*)(lds + MISC_OFF);
    const int tid = threadIdx.x, lane = tid & 63, wave = __builtin_amdgcn_readfirstlane(tid >> 6);
    const int G = gridDim.x; const int bx = blockIdx.x; const int vcu = (G % 8 == 0) ? (bx % 8) * (G / 8) + bx / 8 : bx;
    unsigned char* ws = args.ws;
    gu32* ctl = (gu32*)(ws + WS_CTL);
    for (int u = tid; u < (LDS_BYTES - LDSCTL_OFF) / 4; u += NWAVES * 64) ((LAS unsigned*)(lds + LDSCTL_OFF))[u] = 0u;
    __syncthreads();
    XcdBarrier bar; bar.bar = (unsigned*)(ctl + CW_BAR); bar.x = 0; bar.st = nullptr;
    if (!MK_PER_PHASE) bar = xcd_barrier_post((unsigned*)(ctl + CW_BAR), MISC + 8);
    const int lo = args.ph_lo, hi = args.ph_hi;
#ifndef PH_MASK
#define PH_MASK 0x7fff
#endif
#define IN(k) (((PH_MASK >> (k)) & 1) && lo <= (k) && (k) < hi)
#define SEAM(k) do { if (IN(k) && IN((k) + 1)) xcd_barrier(bar); } while (0)
#ifndef DF_BARRIERS
#define DF_BARRIERS 0
#endif
#define DSEAM(k) do { if (DF_BARRIERS) SEAM(k); } while (0)
    using pg8::Gemm; using pg8::StaticOrder; using pg8::DepOrder; using pg8::EpiKV; using pg8::EpiSwiglu; using pg8::EpiRes; using pg8::EpiZ; using pg8::EpiGate; using pg8::EpiQ; using pg8::gemm_phase; using pg8::bf16_t;
    float* const out = args.out;
    bf16_t* const HB = (bf16_t*)(ws + WS_HB);
    float* const ST0 = (float*)(ws + WS_ST0); float* const ST1 = (float*)(ws + WS_ST1); float* const ST2 = (float*)(ws + WS_ST2); float* const ST3 = (float*)(ws + WS_ST3);

    unsigned* const xtab = (unsigned*)(ctl + CW_XCC);
    if (tid == 0) __hip_atomic_store(xtab + bx, 0x100u | xb_xcc_id(), RLX_AGENT);
    if (IN(0)) { phase_prep<0>(args, lds, tid, wave, lane, vcu, G, nullptr); }
    SEAM(0);
    bool wtall = true;
    if (!MK_PER_PHASE && G == 256 && IN(0) && IN(1)) {
        const unsigned mine = 0x100u | xb_xcc_id();
        const unsigned other = (lane < 32) ? __hip_atomic_load(xtab + (bx & 7) + 8 * lane, RLX_AGENT) : mine;
        wtall = !__all(other == mine);
    }
    unsigned* const dctr = (unsigned*)(ctl + CW_DEP); unsigned* const tmo = (unsigned*)(ctl + 0);
#define DEPC(k) (dctr + (size_t)(k) * 136 * 64)
#define ROT(r) ((bx + G - (r)) % G)
    if (IN(2)) {
        Gemm g{HB, (const bf16_t*)(ws + WS_W13A), MT, 2 * DFF, DM, true}; DepOrder S; S.init(MT, 2 * DFF, G, ROT(0)); S.dep = nullptr; S.need = 0; S.sig = DEPC(0); S.tmo = tmo; S.skew = 1;
        EpiSwiglu E{(bf16_t*)(ws + WS_RACT), ST0, wtall};
        gemm_phase<EpiSwiglu, DepOrder, true, true>(lds, g, S, E);
    }
    DSEAM(2);
    if (IN(3)) {
        Gemm g{(const bf16_t*)(ws + WS_RACT), (const bf16_t*)(ws + WS_W2A), MT, DM, DFF, true}; DepOrder S; S.init(MT, DM, G, ROT(48)); S.dep = DEPC(0); S.need = 22 * 8; S.sig = DEPC(1); S.tmo = tmo;
        EpiRes<false> E{HB, ST1, nullptr, 0.5f, wtall};
        gemm_phase<EpiRes<false>, DepOrder, true, true>(lds, g, S, E);
        Gemm g1{(const bf16_t*)(ws + WS_MEMN), (const bf16_t*)(ws + WS_WMKV), MMEM, 2 * DM, DM, true}; StaticOrder S1; S1.init(MMEM, 2 * DM, G, (G == 256) ? ((bx >= 56 && bx < 120) ? bx - 56 : (1 << 20)) : bx);
        EpiKV E1{out + OFF_MK, out + OFF_MV, (bf16_t*)(ws + WS_KB)};
        gemm_phase<EpiKV, StaticOrder, true, true>(lds, g1, S1, E1);
    }
    DSEAM(3);
    if (IN(4)) {
        Gemm g{HB, (const bf16_t*)(ws + WS_WIN), MT, 6 * 256, DM, true}; DepOrder S; S.init(MT, 6 * 256, G, ROT(120)); S.dep = DEPC(1); S.need = 4 * 8; S.sig = nullptr; S.tmo = tmo;
        EpiZ E{ST1, (bf16_t*)(ws + WS_XA), (bf16_t*)(ws + WS_UU), (bf16_t*)(ws + WS_VV), (bf16_t*)(ws + WS_GATE), (float*)(ws + WS_STV), args.in[12], out + OFF_POOLP, out + OFF_POOLS, 0, wtall};
        gemm_phase<EpiZ, DepOrder, true, true>(lds, g, S, E);
    }
    if (IN(4)) phase_prep<1>(args, lds, tid, wave, lane, 0, 1, (unsigned*)(ctl + CW_Q1));
    SEAM(4);
    if (IN(5)) { phase_mixprep(args, lds, tid, wave, lane, vcu, G); }
    SEAM(5);
    if (IN(6)) {
        Gemm g{HB, (const bf16_t*)(ws + WS_WIN) + (size_t)6 * 256 * DM, MT, 8 * 256, DM, true}; DepOrder S; S.init(MT, 8 * 256, G, ROT(0)); S.dep = nullptr; S.need = 0; S.sig = DEPC(2); S.tmo = tmo;
        EpiZ E{ST1, (bf16_t*)(ws + WS_XA), (bf16_t*)(ws + WS_UU), (bf16_t*)(ws + WS_VV), (bf16_t*)(ws + WS_GATE), (float*)(ws + WS_STV), args.in[12], out + OFF_POOLP, out + OFF_POOLS, 6, wtall};
        gemm_phase<EpiZ, DepOrder, true, true>(lds, g, S, E);
    }
    DSEAM(6);
    if (IN(7)) {
        { Gemm g{(const bf16_t*)(ws + WS_DD), (const bf16_t*)(ws + WS_WA), MT, DM, 512, true}; DepOrder S; S.init(MT, DM, G, ROT(16)); S.dep = DEPC(2); S.need = 8 * 8; S.sig = nullptr; S.tmo = tmo;
          EpiGate<false> E{(const bf16_t*)(ws + WS_GATE), (bf16_t*)(ws + WS_MRG), wtall};
          gemm_phase<EpiGate<false>, DepOrder, true, true>(lds, g, S, E); }
        { Gemm g{(const bf16_t*)(ws + WS_US), (const bf16_t*)(ws + WS_WPB), MT, DM, 512, true}; DepOrder S; S.init(MT, DM, G, ROT(16)); S.dep = nullptr; S.need = 0; S.sig = DEPC(3); S.tmo = tmo;
          EpiGate<true> E{(const bf16_t*)(ws + WS_GATE), (bf16_t*)(ws + WS_MRG), wtall};
          gemm_phase<EpiGate<true>, DepOrder, true, true>(lds, g, S, E); }
    }
    DSEAM(7);
    if (IN(8)) {
        Gemm g{(const bf16_t*)(ws + WS_MRG), (const bf16_t*)(ws + WS_WO), MT, DM, DM, true}; DepOrder S; S.init(MT, DM, G, ROT(24)); S.dep = DEPC(3); S.need = 4 * 8; S.sig = DEPC(4); S.tmo = tmo;
        EpiRes<false> E{HB, ST2, nullptr, 1.0f, wtall};
        gemm_phase<EpiRes<false>, DepOrder, true, true>(lds, g, S, E);
    }
    DSEAM(8);
    if (IN(9)) {
        Gemm g{HB, (const bf16_t*)(ws + WS_WQ), MT, DM, DM, true}; DepOrder S; S.init(MT, DM, G, ROT(32)); S.dep = DEPC(4); S.need = 4 * 8; S.sig = nullptr; S.tmo = tmo;
        EpiQ E{ST2, (bf16_t*)(ws + WS_QB), 1.44269504089f * 0.0625f};
        gemm_phase<EpiQ, DepOrder, true, true>(lds, g, S, E);
    }
    if (IN(9)) phase_prep<2>(args, lds, tid, wave, lane, 0, 1, (unsigned*)(ctl + CW_Q2));
    SEAM(9);
    if (IN(10)) { phase_attention(args, lds, tid, wave, lane, vcu, G); }
    SEAM(10);
    if (IN(11)) {
        Gemm g{(const bf16_t*)(ws + WS_OB), (const bf16_t*)(ws + WS_WCO), MT, DM, DM, true}; DepOrder S; S.init(MT, DM, G, ROT(0)); S.dep = nullptr; S.need = 0; S.sig = DEPC(5); S.tmo = tmo;
        EpiRes<false> E{HB, ST3, nullptr, 1.0f, wtall};
        gemm_phase<EpiRes<false>, DepOrder, true, true>(lds, g, S, E);
    }
    DSEAM(11);
    if (IN(12)) {
        Gemm g{HB, (const bf16_t*)(ws + WS_W13B), MT, 2 * DFF, DM, true}; DepOrder S; S.init(MT, 2 * DFF, G, ROT(8)); S.dep = DEPC(5); S.need = 4 * 8; S.sig = DEPC(6); S.tmo = tmo; S.skew = 1;
        EpiSwiglu E{(bf16_t*)(ws + WS_RACT), ST3, wtall};
        gemm_phase<EpiSwiglu, DepOrder, true, true>(lds, g, S, E);
    }
    DSEAM(12);
    if (IN(13)) {
        Gemm g{(const bf16_t*)(ws + WS_RACT), (const bf16_t*)(ws + WS_W2B), MT, DM, DFF, true}; DepOrder S; S.init(MT, DM, G, ROT(56)); S.dep = DEPC(6); S.need = 22 * 8; S.sig = DEPC(7); S.tmo = tmo;
        EpiRes<false> E{HB, ST0, nullptr, 0.5f, wtall};
        gemm_phase<EpiRes<false>, DepOrder, true, true>(lds, g, S, E);
    }
    DSEAM(13);
    if (IN(14)) { phase_final_q(args, lds, tid, wave, lane, bx, (unsigned*)(ctl + CW_QF), DEPC(7), tmo); }
#undef DEPC
#undef ROT
#undef IN
#undef SEAM
#undef DSEAM
}

extern "C" void kernel_launch(void* const* d_in, const int* in_sizes, int n_in, void* d_out, int out_size, void* d_ws, size_t ws_size, hipStream_t stream) {
    static int grid = 0;
    if (grid == 0) {
        if (n_in != 32 || (size_t)out_size != OUT_TOTAL || ws_size < WS_END) { fprintf(stderr, "kernel_launch: unexpected shapes: n_in %d out %d ws %zu (need %zu)\n", n_in, out_size, ws_size, (size_t)WS_END); grid = -1; return; }
        int dev = 0, cus = 0, per_cu = 0;
        if (hipGetDevice(&dev) != hipSuccess || hipDeviceGetAttribute(&cus, hipDeviceAttributeMultiprocessorCount, dev) != hipSuccess) { grid = -1; return; }
        if (hipFuncSetAttribute((const void*)fwd_kernel, hipFuncAttributeMaxDynamicSharedMemorySize, LDS_BYTES) != hipSuccess) { fprintf(stderr, "kernel_launch: hipFuncSetAttribute failed\n"); grid = -1; return; }
        if (hipOccupancyMaxActiveBlocksPerMultiprocessor(&per_cu, (const void*)fwd_kernel, NWAVES * 64, LDS_BYTES) != hipSuccess || per_cu < 1) { fprintf(stderr, "kernel_launch: occupancy query says %d blocks per CU\n", per_cu); grid = -1; (void)hipGetLastError(); return; }
        grid = cus;
    }
    if (grid < 0) return;
    (void)hipMemsetAsync((char*)d_ws + WS_CTL, 0, CTL_ZERO_BYTES, stream);
    Args a{};
    for (int i = 0; i < 32; ++i) a.in[i] = (const float*)d_in[i];
    a.out = (float*)d_out; a.ws = (unsigned char*)d_ws;
#if MK_PER_PHASE
    for (int p = 0; p < N_PHASES; ++p) { a.ph_lo = p; a.ph_hi = p + 1; hipLaunchKernelGGL(fwd_kernel, dim3(grid), dim3(NWAVES * 64), LDS_BYTES, stream, a); }
#else
    a.ph_lo = 0; a.ph_hi = N_PHASES;
    hipLaunchKernelGGL(fwd_kernel, dim3(grid), dim3(NWAVES * 64), LDS_BYTES, stream, a);
#endif
}
```

```cpp
#include <hip/hip_runtime.h>
#include <cstdio>
#include <cstdint>
namespace pg8 {
#define PG8_LAS __attribute__((address_space(3)))
typedef unsigned short bf16_t;
typedef short bf16x8 __attribute__((ext_vector_type(8)));
typedef float f32x4 __attribute__((ext_vector_type(4)));
typedef unsigned u32x4 __attribute__((ext_vector_type(4)));
constexpr int BM = 256, BK = 64, HALF = 128, HTB = HALF * BK * 2  , STAGE_BYTES = 8 * HTB, NXCD = 8, WGM = 8;

__host__ __device__ __forceinline__ int lds_byte(int r, int c) { const int st = (r >> 4) * 2 + (c >> 5), rr = r & 15, cc = c & 31, ob = rr * 64 + cc * 2; return st * 1024 + (ob ^ (((ob >> 9) & 1) << 5)); }
__host__ __device__ __forceinline__ void stage_rc(int b, int& R, int& C) { const int st = b / 1024, sb = b % 1024, swz = sb ^ (((sb >> 9) & 1) << 5); R = (st >> 1) * 16 + swz / 64; C = (st & 1) * 32 + (swz % 64) / 2; }
__host__ __device__ __forceinline__ int perm32(int rho) { const int n = rho >> 4, i = rho & 15; return 8 * (i >> 2) + 4 * n + (i & 3); }

__host__ __device__ __forceinline__ int inv_perm32(int x) { return 16 * ((x >> 2) & 1) + 4 * (x >> 3) + (x & 3); }
__host__ __device__ __forceinline__ int img_off_a(int rin, int c) { return (rin >> 7) * 16384 + lds_byte(rin & 127, c); }
__host__ __device__ __forceinline__ int img_off_w(int rin, int c) { const int r = rin & 127; return (rin >> 7) * 16384 + lds_byte((r & ~31) + inv_perm32(r & 31), c); }
__host__ __device__ __forceinline__ size_t hb_byte(int row, int col) { return (size_t)((row >> 8) * 16 + (col >> 6)) * 32768 + img_off_a(row & 255, col & 63); }
__host__ __device__ __forceinline__ size_t k512_byte(int row, int col) { return (size_t)((row >> 8) * 8 + (col >> 6)) * 32768 + img_off_a(row & 255, col & 63); }
__host__ __device__ __forceinline__ size_t gate_byte(int row, int col) { return (size_t)((row >> 8) * 32 + (col >> 6)) * 32768 + img_off_a(row & 255, col & 63); }
struct Unit { int pm, pn; };
struct Gemm { const bf16_t* A; const bf16_t* Bt; int M, N, K; bool ablk = false; };

struct StaticOrder {
    int nM, nN, nwg, G, c;
    __host__ __device__ void init(int M, int N, int G_, int c_) { nM = M / BM; nN = N / BM; nwg = nM * nN; G = G_; c = c_; }
    __host__ __device__ bool next(int i, Unit& u) const {
        const long L = (long)i * G + c; if (L >= nwg) return false;
        int wgid = (int)L; { const int q = nwg / NXCD, r = nwg % NXCD, xcd = wgid % NXCD, off = wgid / NXCD; wgid = (xcd < r ? xcd * (q + 1) : r * (q + 1) + (xcd - r) * q) + off; }
        const int nig = WGM * nN, gid = wgid / nig, fm = gid * WGM, gsz = (nM - fm) < WGM ? (nM - fm) : WGM;
        u.pm = fm + ((wgid % nig) % gsz); u.pn = (wgid % nig) / gsz; return true;
    }
    __device__ __forceinline__ void a_ready(const Unit&) const {}
    __device__ __forceinline__ void done(const Unit&) const {}
    static constexpr bool HAS_SIG = false;
    __device__ __forceinline__ void signal(int, int) const {}
};
struct DepOrder : StaticOrder {
    static constexpr bool HAS_SIG = true;
    const unsigned* dep; unsigned need; unsigned* sig; unsigned* tmo; int skew = 0; mutable int okpm = -1;
    __device__ bool next(int i, Unit& u) const {
        if (G != 256 || nM != 130) return StaticOrder::next(i, u);
        const int x = c & 7, k = c >> 3, nP = 16 * nN; int li = i * 32 + k;
        if (skew) {
            if (k == 6 && i >= 9) return false;
            if ((k == 17 || k == 18) && i == 11) li = 32 * (9 + (k - 17)) + 6;
        }
        if (li < nP) { const int per = 8 * nN, g = li / per, w = li - g * per; u.pm = 16 * x + 8 * g + (w & 7); u.pn = w >> 3; return true; }
        const int sidx = (li - nP) * 8 + x;
        if (sidx >= 2 * nN) return false;
        u.pm = 128 + (sidx & 1); u.pn = sidx >> 1; return true;
    }
    __device__ __forceinline__ void a_ready(const Unit& u) const {
        if (dep == nullptr || u.pm == okpm) return;
        okpm = u.pm;
        if (threadIdx.x < 64) {
            unsigned polls = 0;
            while ((unsigned)__builtin_amdgcn_readfirstlane(__hip_atomic_load(dep + 64 * u.pm, __ATOMIC_RELAXED, __HIP_MEMORY_SCOPE_AGENT)) < need) {
                if ((++polls & 1023u) == 0u) { if (__builtin_amdgcn_readfirstlane(__hip_atomic_load(tmo, __ATOMIC_RELAXED, __HIP_MEMORY_SCOPE_AGENT)) != 0u) break;
                    if (polls > (1u << 22)) { if (threadIdx.x == 0) __hip_atomic_store(tmo, 1u, __ATOMIC_RELAXED, __HIP_MEMORY_SCOPE_AGENT); break; } }
                __builtin_amdgcn_s_sleep(2); }
            __builtin_amdgcn_fence(__ATOMIC_ACQUIRE, "agent");
            asm volatile("s_waitcnt vmcnt(0)" ::: "memory");
        }
        asm volatile("" ::: "memory"); __builtin_amdgcn_s_barrier(); asm volatile("" ::: "memory");
    }
    __device__ __forceinline__ void signal(int pm, int lane) const { if (sig != nullptr && lane == 0) __hip_atomic_fetch_add(sig + 64 * pm, 1u, __ATOMIC_RELAXED, __HIP_MEMORY_SCOPE_AGENT); }
};

typedef __bf16 bf16x2_t __attribute__((ext_vector_type(2)));
typedef float f32x2_t __attribute__((ext_vector_type(2)));
__device__ __forceinline__ unsigned cvt_pk_bf16(float lo, float hi) { const f32x2_t v = {lo, hi}; const bf16x2_t b = __builtin_convertvector(v, bf16x2_t); return __builtin_bit_cast(unsigned, b); }
typedef float f32x2 __attribute__((ext_vector_type(2)));
constexpr float RMS_EPS = 1e-6f;
__device__ __forceinline__ float fast_sigmoid(float x) { return __builtin_amdgcn_rcpf(1.0f + __builtin_amdgcn_exp2f(-1.44269504089f * x)); }
__device__ __forceinline__ float silu_f(float a) { return a * fast_sigmoid(a); }
__device__ __forceinline__ float gelu_tanh_f(float x) { return x * fast_sigmoid(1.5957691216f * (x + 0.044715f * x * x * x)); }
__device__ __forceinline__ f32x2 sigmoid2(f32x2 x) { const f32x2 t = x * -1.44269504089f; f32x2 e; e.x = __builtin_amdgcn_exp2f(t.x); e.y = __builtin_amdgcn_exp2f(t.y);
    const f32x2 d = e + 1.0f; f32x2 r; r.x = __builtin_amdgcn_rcpf(d.x); r.y = __builtin_amdgcn_rcpf(d.y); return r; }
__device__ __forceinline__ f32x2 gelu_tanh2(f32x2 x) { const f32x2 y = (x * x) * 0.044715f + 1.0f; return x * sigmoid2((y * x) * 1.5957691216f); }
__device__ __forceinline__ float bf_lo(unsigned w) { return __builtin_bit_cast(float, w << 16); }
__device__ __forceinline__ float bf_hi(unsigned w) { return __builtin_bit_cast(float, w & 0xffff0000u); }
__device__ __forceinline__ float row_rinv(const float* st, int row) {
    const f32x4* p = (const f32x4*)(st + (size_t)row * 16);
    const f32x4 a = p[0], b = p[1], c = p[2], d = p[3];
    const float s = (((a.x + a.y) + (a.z + a.w)) + ((b.x + b.y) + (b.z + b.w))) + (((c.x + c.y) + (c.z + c.w)) + ((d.x + d.y) + (d.z + d.w)));
    return __builtin_amdgcn_rsqf(s * (1.0f / 1024.0f) + RMS_EPS);
}
__device__ __forceinline__ void rows_rinv(const float* st, int row0, int fq, float (&r)[2][4]) {
    f32x4 p[2][4];
#pragma unroll
    for (int ai = 0; ai < 2; ++ai)
#pragma unroll
        for (int m = 0; m < 4; ++m) p[ai][m] = *(const f32x4*)(st + (size_t)(row0 + ai * HALF + m * 16) * 16 + 4 * fq);
#pragma unroll
    for (int ai = 0; ai < 2; ++ai)
#pragma unroll
        for (int m = 0; m < 4; ++m) { float s = (p[ai][m].x + p[ai][m].y) + (p[ai][m].z + p[ai][m].w); s += __shfl_xor(s, 16); s += __shfl_xor(s, 32); r[ai][m] = __builtin_amdgcn_rsqf(s * (1.0f / 1024.0f) + RMS_EPS); }
}
__device__ __forceinline__ u32x4 pack8(const float (&o)[8]) { u32x4 w; w.x = cvt_pk_bf16(o[0], o[1]); w.y = cvt_pk_bf16(o[2], o[3]); w.z = cvt_pk_bf16(o[4], o[5]); w.w = cvt_pk_bf16(o[6], o[7]); return w; }

__device__ __forceinline__ void store16_sel(void* p, u32x4 v, bool wt) { if (wt) asm volatile("global_store_dwordx4 %0, %1, off sc1\n\ts_nop 1" :: "v"(p), "v"(v) : "memory"); else *(u32x4*)p = v; }
__device__ __forceinline__ void store16_wt(void* p, u32x4 v) { asm volatile("global_store_dwordx4 %0, %1, off sc1\n\ts_nop 1" :: "v"(p), "v"(v) : "memory"); }
struct EpiSwiglu {
    static constexpr bool PERM = true, AFTER_DRAIN = false;
    bf16_t* O; const float* st; bool wtall;
    __device__ __forceinline__ void operator()(const f32x4 (&acc)[2][2][4][2], const Unit& u, int wr, int wc, int fr_, int fq_) const {
        int fr = fr_, fq = fq_; asm volatile("" : "+v"(fr), "+v"(fq));
        const int row0 = u.pm * BM + wr * 64 + fr;
        unsigned char* const Ob = (unsigned char*)O + (size_t)(u.pm * (2816 / 64) + u.pn * 2 + (wc >> 1)) * 32768;
        float rr[2][4]; rows_rinv(st, row0, fq, rr);
#pragma unroll
        for (int ai = 0; ai < 2; ++ai)
#pragma unroll
            for (int m = 0; m < 4; ++m) {
                const int row = row0 + ai * HALF + m * 16;
                const float r = rr[ai][m];
                float o[8];
#pragma unroll
                for (int n = 0; n < 2; ++n)
#pragma unroll
                    for (int j = 0; j < 4; j += 2) { const f32x2 a = (f32x2){acc[ai][0][m][n][j], acc[ai][0][m][n][j + 1]} * r, b = (f32x2){acc[ai][1][m][n][j], acc[ai][1][m][n][j + 1]} * r;
                        const f32x2 v = (a * sigmoid2(a)) * b; o[n * 4 + j] = v.x; o[n * 4 + j + 1] = v.y; }
                store16_sel(Ob + img_off_a(wr * 64 + fr + ai * HALF + m * 16, (wc & 1) * 32 + 8 * fq), pack8(o), wtall || u.pm >= 128);
                asm volatile("" ::: "memory");
            }
    }
};
template <bool FINAL> struct EpiRes {
    static constexpr bool PERM = true, AFTER_DRAIN = false;
    bf16_t* hb; float* st; float* out; float scale; bool wtall;
    __device__ __forceinline__ void operator()(const f32x4 (&acc)[2][2][4][2], const Unit& u, int wr, int wc, int fr_, int fq_) const {
        int fr = fr_, fq = fq_; asm volatile("" : "+v"(fr), "+v"(fq));
        const int row0 = u.pm * BM + wr * 64 + fr, col0 = u.pn * BM + wc * 32 + 8 * fq;
#pragma unroll
        for (int ai = 0; ai < 2; ++ai) {
            u32x4 hv[4][2];
#pragma unroll
            for (int m = 0; m < 4; ++m)
#pragma unroll
                for (int bj = 0; bj < 2; ++bj) hv[m][bj] = *(const u32x4*)((const unsigned char*)hb + hb_byte(row0 + ai * HALF + m * 16, col0 + bj * HALF));
#pragma unroll
            for (int m = 0; m < 4; ++m) {
                const int row = row0 + ai * HALF + m * 16;
                float ss = 0.f;
#pragma unroll
                for (int bj = 0; bj < 2; ++bj) {
                    bf16_t* hp = (bf16_t*)((unsigned char*)hb + hb_byte(row, col0 + bj * HALF));
                    const u32x4 b = hv[m][bj];
                    f32x4 v0 = acc[ai][bj][m][0] * scale, v1 = acc[ai][bj][m][1] * scale;
                    v0.x += bf_lo(b.x); v0.y += bf_hi(b.x); v0.z += bf_lo(b.y); v0.w += bf_hi(b.y); v1.x += bf_lo(b.z); v1.y += bf_hi(b.z); v1.z += bf_lo(b.w); v1.w += bf_hi(b.w);
                    if (FINAL) { float* op = out + (size_t)row * 1024 + col0 + bj * HALF; *(f32x4*)op = v0; *(f32x4*)(op + 4) = v1; }
                    else { u32x4 w; w.x = cvt_pk_bf16(v0.x, v0.y); w.y = cvt_pk_bf16(v0.z, v0.w); w.z = cvt_pk_bf16(v1.x, v1.y); w.w = cvt_pk_bf16(v1.z, v1.w); store16_sel(hp, w, wtall || u.pm >= 128);
                        ss += ((v0.x * v0.x + v0.y * v0.y) + (v0.z * v0.z + v0.w * v0.w)) + ((v1.x * v1.x + v1.y * v1.y) + (v1.z * v1.z + v1.w * v1.w)); }
                }
                if (!FINAL) { ss += __shfl_xor(ss, 16); ss += __shfl_xor(ss, 32); if (fq == 0) { if (wtall || u.pm >= 128) __hip_atomic_store(st + (size_t)row * 16 + u.pn * 4 + wc, ss, __ATOMIC_RELAXED, __HIP_MEMORY_SCOPE_AGENT); else st[(size_t)row * 16 + u.pn * 4 + wc] = ss; } }
            }
            asm volatile("" ::: "memory");
        }
    }
};
struct EpiZ {
    static constexpr bool PERM = true, AFTER_DRAIN = false;
    const float* st; bf16_t* xa; bf16_t* uu; bf16_t* vv; bf16_t* gate; float* stv; const float* b_gate; float* poolp; float* pools; int pn_off; bool wtall;
    __device__ __forceinline__ void operator()(const f32x4 (&acc)[2][2][4][2], const Unit& u, int wr, int wc, int fr_, int fq_) const {
        int fr = fr_, fq = fq_; asm volatile("" : "+v"(fr), "+v"(fq));
        const int row0 = u.pm * BM + wr * 64 + fr; const int pn = u.pn + pn_off;
        const int kind = pn < 2 ? 0 : (pn < 4 ? 1 : (pn < 6 ? 2 : 3));
        const int tbase = pn < 2 ? 0 : (pn < 4 ? 2 : (pn < 6 ? 4 : 6));
        const int lc0 = (pn - tbase) * BM + wc * 32 + 8 * fq;
        float rr[2][4]; rows_rinv(st, row0, fq, rr);
        if (kind == 0) {
#pragma unroll
            for (int ai = 0; ai < 2; ++ai)
#pragma unroll
                for (int m = 0; m < 4; ++m) {
                    const int row = row0 + ai * HALF + m * 16; const float r = rr[ai][m];
                    float* pdst = nullptr;
                    if (row < 32768) { const int t = row & 4095; if (t >= 4081) pdst = poolp + (size_t)((row >> 12) * 15 + (t - 4081)) * 512; }
                    else { const int sr = row - 32768, t = sr & 15; if (t >= 1) pdst = pools + (size_t)((sr >> 4) * 15 + (t - 1)) * 512; }
#pragma unroll
                    for (int bj = 0; bj < 2; ++bj) {
                        const f32x4 v0 = acc[ai][bj][m][0] * r, v1 = acc[ai][bj][m][1] * r; const int c = lc0 + bj * HALF;
                        u32x4 w; w.x = cvt_pk_bf16(v0.x, v0.y); w.y = cvt_pk_bf16(v0.z, v0.w); w.z = cvt_pk_bf16(v1.x, v1.y); w.w = cvt_pk_bf16(v1.z, v1.w);
                        *(u32x4*)(xa + (size_t)row * 512 + c) = w;
                        if (pdst) { *(f32x4*)(pdst + c) = v0; *(f32x4*)(pdst + c + 4) = v1; }
                    }
                }
        } else if (kind == 1) {
#pragma unroll
            for (int ai = 0; ai < 2; ++ai)
#pragma unroll
                for (int m = 0; m < 4; ++m) {
                    const int row = row0 + ai * HALF + m * 16; const float r = rr[ai][m];
#pragma unroll
                    for (int bj = 0; bj < 2; ++bj) {
                        float o[8];
#pragma unroll
                        for (int n = 0; n < 2; ++n)
#pragma unroll
                            for (int j = 0; j < 4; j += 2) { const f32x2 v = gelu_tanh2((f32x2){acc[ai][bj][m][n][j], acc[ai][bj][m][n][j + 1]} * r); o[n * 4 + j] = v.x; o[n * 4 + j + 1] = v.y; }
                        *(u32x4*)(uu + (size_t)row * 512 + lc0 + bj * HALF) = pack8(o);
                    }
                }
        } else if (kind == 2) {
#pragma unroll
            for (int ai = 0; ai < 2; ++ai)
#pragma unroll
                for (int m = 0; m < 4; ++m) {
                    const int row = row0 + ai * HALF + m * 16; const float r = rr[ai][m];
                    float s1 = 0.f, s2 = 0.f;
#pragma unroll
                    for (int bj = 0; bj < 2; ++bj) {
                        float o[8];
#pragma unroll
                        for (int n = 0; n < 2; ++n)
#pragma unroll
                            for (int j = 0; j < 4; j += 2) { const f32x2 g = gelu_tanh2((f32x2){acc[ai][bj][m][n][j], acc[ai][bj][m][n][j + 1]} * r); o[n * 4 + j] = g.x; o[n * 4 + j + 1] = g.y; s1 += g.x + g.y; s2 += g.x * g.x + g.y * g.y; }
                        *(u32x4*)(vv + (size_t)row * 512 + lc0 + bj * HALF) = pack8(o);
                    }
                    s1 += __shfl_xor(s1, 16); s1 += __shfl_xor(s1, 32); s2 += __shfl_xor(s2, 16); s2 += __shfl_xor(s2, 32);
                    if (fq == 0) { f32x2 sv; sv.x = s1; sv.y = s2; *(f32x2*)(stv + (size_t)row * 16 + ((pn - 4) * 4 + wc) * 2) = sv; }
                }
        } else {
            f32x4 bv[2][2];
#pragma unroll
            for (int bj = 0; bj < 2; ++bj)
#pragma unroll
                for (int n = 0; n < 2; ++n) bv[bj][n] = *(const f32x4*)(b_gate + lc0 + bj * HALF + 4 * n);
#pragma unroll
            for (int ai = 0; ai < 2; ++ai)
#pragma unroll
                for (int m = 0; m < 4; ++m) {
                    const int row = row0 + ai * HALF + m * 16; const float r = rr[ai][m];
#pragma unroll
                    for (int bj = 0; bj < 2; ++bj) {
                        float o[8];
#pragma unroll
                        for (int n = 0; n < 2; ++n)
#pragma unroll
                            for (int j = 0; j < 4; j += 2) { const f32x2 v = sigmoid2((f32x2){acc[ai][bj][m][n][j], acc[ai][bj][m][n][j + 1]} * r + (f32x2){bv[bj][n][j], bv[bj][n][j + 1]}); o[n * 4 + j] = v.x; o[n * 4 + j + 1] = v.y; }
                        store16_sel((unsigned char*)gate + gate_byte(row, lc0 + bj * HALF), pack8(o), wtall || u.pm >= 128);
                    }
                }
        }
    }
};
template <bool ADD> struct EpiGate {
    static constexpr bool PERM = true, AFTER_DRAIN = false;
    const bf16_t* gate; bf16_t* mrg; bool wtall;
    __device__ __forceinline__ void operator()(const f32x4 (&acc)[2][2][4][2], const Unit& u, int wr, int wc, int fr_, int fq_) const {
        int fr = fr_, fq = fq_; asm volatile("" : "+v"(fr), "+v"(fq));
        const int row0 = u.pm * BM + wr * 64 + fr, col0 = u.pn * BM + wc * 32 + 8 * fq;
#pragma unroll
        for (int ai = 0; ai < 2; ++ai)
#pragma unroll
            for (int mp = 0; mp < 2; ++mp) {
                u32x4 gv[2][2], tv[2][2];
#pragma unroll
                for (int mm = 0; mm < 2; ++mm)
#pragma unroll
                    for (int bj = 0; bj < 2; ++bj) { const int row = row0 + ai * HALF + (2 * mp + mm) * 16, c = col0 + bj * HALF;
                        gv[mm][bj] = *(const u32x4*)((const unsigned char*)gate + gate_byte(row, (ADD ? 1024 : 0) + c));
                        if (ADD) tv[mm][bj] = *(const u32x4*)((const unsigned char*)mrg + hb_byte(row, c)); }
#pragma unroll
                for (int mm = 0; mm < 2; ++mm) {
                    const int m = 2 * mp + mm; const int row = row0 + ai * HALF + m * 16;
#pragma unroll
                    for (int bj = 0; bj < 2; ++bj) {
                        const int c = col0 + bj * HALF;
                        const u32x4 g = gv[mm][bj];
                        float o[8];
                        o[0] = acc[ai][bj][m][0].x * bf_lo(g.x); o[1] = acc[ai][bj][m][0].y * bf_hi(g.x); o[2] = acc[ai][bj][m][0].z * bf_lo(g.y); o[3] = acc[ai][bj][m][0].w * bf_hi(g.y);
                        o[4] = acc[ai][bj][m][1].x * bf_lo(g.z); o[5] = acc[ai][bj][m][1].y * bf_hi(g.z); o[6] = acc[ai][bj][m][1].z * bf_lo(g.w); o[7] = acc[ai][bj][m][1].w * bf_hi(g.w);
                        bf16_t* mpt = (bf16_t*)((unsigned char*)mrg + hb_byte(row, c));
                        if (ADD) { const u32x4 t = tv[mm][bj];
                            o[0] += bf_lo(t.x); o[1] += bf_hi(t.x); o[2] += bf_lo(t.y); o[3] += bf_hi(t.y); o[4] += bf_lo(t.z); o[5] += bf_hi(t.z); o[6] += bf_lo(t.w); o[7] += bf_hi(t.w); }
                        if (ADD) store16_sel(mpt, pack8(o), wtall || u.pm >= 128); else *(u32x4*)mpt = pack8(o);
                    }
                }
                asm volatile("" ::: "memory");
            }
    }
};
struct EpiQ {
    static constexpr bool PERM = true, AFTER_DRAIN = false;
    const float* st; bf16_t* q; float qscale;
    __device__ __forceinline__ void operator()(const f32x4 (&acc)[2][2][4][2], const Unit& u, int wr, int wc, int fr_, int fq_) const {
        int fr = fr_, fq = fq_; asm volatile("" : "+v"(fr), "+v"(fq));
        const int row0 = u.pm * BM + wr * 64 + fr, col0 = u.pn * BM + wc * 32 + 8 * fq;
        float rr[2][4]; rows_rinv(st, row0, fq, rr);
#pragma unroll
        for (int ai = 0; ai < 2; ++ai)
#pragma unroll
            for (int m = 0; m < 4; ++m) {
                const int row = row0 + ai * HALF + m * 16; const float r = rr[ai][m] * qscale;
#pragma unroll
                for (int bj = 0; bj < 2; ++bj) {
                    const f32x4 v0 = acc[ai][bj][m][0] * r, v1 = acc[ai][bj][m][1] * r;
                    u32x4 w; w.x = cvt_pk_bf16(v0.x, v0.y); w.y = cvt_pk_bf16(v0.z, v0.w); w.z = cvt_pk_bf16(v1.x, v1.y); w.w = cvt_pk_bf16(v1.z, v1.w);
                    *(u32x4*)((unsigned char*)q + hb_byte(row, col0 + bj * HALF)) = w;
                }
            }
    }
};
struct EpiKV {
    static constexpr bool PERM = true, AFTER_DRAIN = false;
    float* out_k; float* out_v; bf16_t* kb;
    __device__ __forceinline__ void operator()(const f32x4 (&acc)[2][2][4][2], const Unit& u, int wr, int wc, int fr_, int fq_) const {
        int fr = fr_, fq = fq_; asm volatile("" : "+v"(fr), "+v"(fq));
        const int row0 = u.pm * BM + wr * 64 + fr; const bool isk = u.pn < 4;
        const int col0 = (isk ? u.pn : u.pn - 4) * BM + wc * 32 + 8 * fq; float* of = isk ? out_k : out_v;
#pragma unroll
        for (int ai = 0; ai < 2; ++ai)
#pragma unroll
            for (int m = 0; m < 4; ++m) {
                const int row = row0 + ai * HALF + m * 16;
#pragma unroll
                for (int bj = 0; bj < 2; ++bj) {
                    const f32x4 v0 = acc[ai][bj][m][0], v1 = acc[ai][bj][m][1]; const int c = col0 + bj * HALF;
                    float* op = of + (size_t)row * 1024 + c; if (isk) { __builtin_nontemporal_store(v0, (f32x4*)op); __builtin_nontemporal_store(v1, (f32x4*)(op + 4)); } else { *(f32x4*)op = v0; *(f32x4*)(op + 4) = v1; }
                    if (isk) { u32x4 w; w.x = cvt_pk_bf16(v0.x, v0.y); w.y = cvt_pk_bf16(v0.z, v0.w); w.z = cvt_pk_bf16(v1.x, v1.y); w.w = cvt_pk_bf16(v1.z, v1.w); *(u32x4*)(kb + (size_t)row * 1024 + c) = w; }
                }
            }
    }
};

__device__ __forceinline__ void glds16x2_sv(const void* sbase, unsigned voff0, unsigned voff1, unsigned lds_dst) {
    unsigned keep;
    asm volatile("s_mov_b32 %0, m0\n\ts_mov_b32 m0, %4\n\ts_nop 0\n\tglobal_load_lds_dwordx4 %1, %3\n\ts_add_u32 m0, %4, 0x2000\n\ts_nop 0\n\tglobal_load_lds_dwordx4 %2, %3\n\ts_mov_b32 m0, %0"
                 : "=&s"(keep) : "v"(voff0), "v"(voff1), "s"(sbase), "s"(lds_dst) : "memory", "scc");
}
template <class Epi, class Sched, bool ALIGN_EPI = false, bool SP2 = false>
__device__ __forceinline__ void gemm_phase(PG8_LAS unsigned char* lds, const Gemm g, const Sched& S, const Epi& E) {
    const int tid = threadIdx.x, wid = __builtin_amdgcn_readfirstlane(tid >> 6), lane = tid & 63, wr = wid >> 2, wc = wid & 3, fr = lane & 15, fq = lane >> 4;
    const int K = g.K, nt = K / BK;
    unsigned voffA[2], voffB[2];
#pragma unroll
    for (int i = 0; i < 2; ++i) { int R, C; stage_rc(tid * 16 + i * 8192, R, C); const int Rb = Epi::PERM ? ((R & ~31) + perm32(R & 31)) : R;
        voffA[i] = g.ablk ? (unsigned)(tid * 16 + i * 8192) : (unsigned)(R * K + C) * 2u; voffB[i] = (unsigned)(tid * 16 + i * 8192); (void)Rb; }
    const size_t kstep = (size_t)(BK * 2);
    const size_t hstep = (size_t)HALF * K * 2;
    const size_t tstep = 2 * hstep;
    const size_t bkstep = (size_t)(BM * BK * 2), bhstep = (size_t)(HALF * BK * 2), btstep = (size_t)nt * (BM * BK * 2);
    const size_t akstep = g.ablk ? (size_t)(BM * BK * 2) : kstep, ahstep = g.ablk ? (size_t)(HALF * BK * 2) : hstep, atstep = g.ablk ? (size_t)nt * (BM * BK * 2) : tstep;
    const unsigned ldsw = (unsigned)wid * 1024u;
    const unsigned ldsb = (unsigned)__builtin_amdgcn_readfirstlane((int)((unsigned)(size_t)lds + ldsw));
    const int aoff = lds_byte(wr * 64 + fr, fq * 8), boff = lds_byte(wc * 32 + fr, fq * 8);
#define PG8_SA(b, h) (((b) * 2 + (h)) * HTB)
#define PG8_SB(b, h) ((4 + (b) * 2 + (h)) * HTB)
#define PG8_STAGE(bufoff, gbase, voff) glds16x2_sv((const void*)(gbase), (voff)[0], (voff)[1], ldsb + (unsigned)(bufoff))
#define PG8_LDA(dst, b, h) do { _Pragma("unroll") for (int m = 0; m < 4; ++m) _Pragma("unroll") for (int k = 0; k < 2; ++k) dst[m][k] = *(const PG8_LAS bf16x8*)(lds + PG8_SA(b, h) + aoff + m * 2048 + k * 1024); } while (0)
#define PG8_LDB(dst, b, h) do { _Pragma("unroll") for (int n = 0; n < 2; ++n) _Pragma("unroll") for (int k = 0; k < 2; ++k) dst[n][k] = *(const PG8_LAS bf16x8*)(lds + PG8_SB(b, h) + boff + n * 2048 + k * 1024); } while (0)
#define PG8_MMA(ai, bj, At, Bt) do { __builtin_amdgcn_s_setprio(1); _Pragma("unroll") for (int m = 0; m < 4; ++m) _Pragma("unroll") for (int n = 0; n < 2; ++n) _Pragma("unroll") for (int k = 0; k < 2; ++k) \
        acc[ai][bj][m][n] = __builtin_amdgcn_mfma_f32_16x16x32_bf16(Bt[n][k], At[m][k], acc[ai][bj][m][n], 0, 0, 0); __builtin_amdgcn_s_setprio(0); } while (0)
#define PG8_ZERO(ai) do { if (t == 0) { _Pragma("unroll") for (int b = 0; b < 2; ++b) _Pragma("unroll") for (int m = 0; m < 4; ++m) _Pragma("unroll") for (int n = 0; n < 2; ++n) acc[ai][b][m][n] = (f32x4){0.f, 0.f, 0.f, 0.f}; } } while (0)
#define PG8_WAIT_V(n) asm volatile("s_waitcnt vmcnt(" #n ")" ::: "memory")
#define PG8_WAIT_L(n) asm volatile("s_waitcnt lgkmcnt(" #n ")" ::: "memory")
#define PG8_BAR __builtin_amdgcn_s_barrier()
#define PG8_SCHED __builtin_amdgcn_sched_barrier(0)
    Unit cur, nxt; int ui = 0; int pend = -1;
    if (!S.next(0, cur)) return;
    f32x4 acc[2][2][4][2];
#pragma unroll
    for (int a = 0; a < 2; ++a)
#pragma unroll
        for (int b = 0; b < 2; ++b)
#pragma unroll
            for (int m = 0; m < 4; ++m)
#pragma unroll
                for (int n = 0; n < 2; ++n) acc[a][b][m][n] = (f32x4){0.f, 0.f, 0.f, 0.f};
    bf16x8 At[4][2], B0[2][2], B1[2][2];
    const char* cA = (const char*)g.A + (size_t)cur.pm * atstep; const char* cB = (const char*)g.Bt + (size_t)cur.pn * btstep;
    S.a_ready(cur);
    if constexpr (SP2) {
        PG8_STAGE(PG8_SB(0, 0), cB, voffB); PG8_STAGE(PG8_SB(0, 1), cB + bhstep, voffB); PG8_STAGE(PG8_SA(0, 0), cA, voffA); PG8_STAGE(PG8_SA(0, 1), cA + ahstep, voffA);
        if (wr == 1) PG8_BAR;
        PG8_WAIT_V(2); PG8_BAR;
        PG8_STAGE(PG8_SB(1, 0), cB + bkstep, voffB); PG8_STAGE(PG8_SA(1, 0), cA + akstep, voffA); PG8_STAGE(PG8_SB(1, 1), cB + bhstep + bkstep, voffB);
        PG8_WAIT_V(6); PG8_BAR;
    } else {
        PG8_STAGE(PG8_SB(0, 0), cB, voffB); PG8_STAGE(PG8_SA(0, 0), cA, voffA); PG8_STAGE(PG8_SB(0, 1), cB + bhstep, voffB); PG8_STAGE(PG8_SA(0, 1), cA + ahstep, voffA);
        if (wr == 1) PG8_BAR;
        PG8_WAIT_V(4); PG8_BAR;
        PG8_STAGE(PG8_SB(1, 0), cB + bkstep, voffB); PG8_STAGE(PG8_SA(1, 0), cA + akstep, voffA); PG8_STAGE(PG8_SB(1, 1), cB + bhstep + bkstep, voffB);
        PG8_WAIT_V(6); PG8_BAR;
    }
    for (;;) {
        const bool has_next = S.next(ui + 1, nxt);
        const char* nA = has_next ? (const char*)g.A + (size_t)nxt.pm * atstep : cA; const char* nB = has_next ? (const char*)g.Bt + (size_t)nxt.pn * btstep : cB;
        for (int t = 0; t < nt; t += 2) {
            const bool last = (t == nt - 2);
            if constexpr (Sched::HAS_SIG) { if (t == 2 && pend >= 0) { S.signal(pend, lane); pend = -1; } }
            const char* a1 = cA + (size_t)(t + 1) * akstep;
            const char* a2 = last ? nA : cA + (size_t)(t + 2) * akstep; const char* b2 = last ? nB : cB + (size_t)(t + 2) * bkstep;
            const char* a3 = a2 + akstep; const char* b3 = b2 + bkstep;
            if (last && has_next) S.a_ready(nxt);
            if constexpr (SP2) {
            PG8_LDB(B0, 0, 0); PG8_LDB(B1, 0, 1); PG8_SCHED; PG8_LDA(At, 0, 0); PG8_STAGE(PG8_SA(1, 1), a1 + ahstep, voffA); PG8_ZERO(0);
            PG8_WAIT_V(8); PG8_WAIT_L(0); PG8_BAR; PG8_MMA(0, 0, At, B0); PG8_MMA(0, 1, At, B1); PG8_BAR; PG8_SCHED;
            PG8_LDA(At, 0, 1); PG8_STAGE(PG8_SB(0, 0), b2, voffB); PG8_STAGE(PG8_SB(0, 1), b2 + bhstep, voffB); PG8_STAGE(PG8_SA(0, 0), a2, voffA); PG8_ZERO(1);
            PG8_WAIT_V(8); PG8_WAIT_L(0); PG8_BAR; PG8_MMA(1, 0, At, B0); PG8_MMA(1, 1, At, B1); PG8_BAR; PG8_SCHED;
            PG8_LDB(B0, 1, 0); PG8_LDB(B1, 1, 1); PG8_SCHED; PG8_LDA(At, 1, 0); PG8_STAGE(PG8_SA(0, 1), a2 + ahstep, voffA);
            PG8_WAIT_V(8); PG8_WAIT_L(0); PG8_BAR; PG8_MMA(0, 0, At, B0); PG8_MMA(0, 1, At, B1); PG8_BAR; PG8_SCHED;
            PG8_LDA(At, 1, 1); PG8_STAGE(PG8_SB(1, 0), b3, voffB); PG8_STAGE(PG8_SB(1, 1), b3 + bhstep, voffB); PG8_STAGE(PG8_SA(1, 0), a3, voffA);
            PG8_WAIT_V(8); PG8_WAIT_L(0); PG8_BAR; PG8_MMA(1, 0, At, B0); PG8_MMA(1, 1, At, B1); PG8_BAR; PG8_SCHED;
            } else {
            PG8_LDB(B0, 0, 0); PG8_SCHED; PG8_LDA(At, 0, 0); PG8_STAGE(PG8_SA(1, 1), a1 + ahstep, voffA);
            PG8_WAIT_L(8); PG8_BAR; PG8_WAIT_L(0); PG8_MMA(0, 0, At, B0); PG8_BAR; PG8_SCHED;
            PG8_LDB(B1, 0, 1); PG8_STAGE(PG8_SB(0, 0), b2, voffB);
            PG8_BAR; PG8_WAIT_L(0); PG8_MMA(0, 1, At, B1); PG8_BAR;
            PG8_LDA(At, 0, 1); PG8_STAGE(PG8_SA(0, 0), a2, voffA);
            PG8_BAR; PG8_WAIT_L(0); PG8_MMA(1, 0, At, B0); PG8_BAR; PG8_SCHED;
            PG8_STAGE(PG8_SB(0, 1), b2 + bhstep, voffB);
            PG8_WAIT_V(6); PG8_BAR; PG8_MMA(1, 1, At, B1); PG8_BAR;
            PG8_LDB(B0, 1, 0); PG8_SCHED; PG8_LDA(At, 1, 0); PG8_STAGE(PG8_SA(0, 1), a2 + ahstep, voffA);
            PG8_WAIT_L(8); PG8_BAR; PG8_WAIT_L(0); PG8_MMA(0, 0, At, B0); PG8_BAR; PG8_SCHED;
            PG8_LDB(B1, 1, 1); PG8_STAGE(PG8_SB(1, 0), b3, voffB);
            PG8_BAR; PG8_WAIT_L(0); PG8_MMA(0, 1, At, B1); PG8_BAR;
            PG8_LDA(At, 1, 1); PG8_STAGE(PG8_SA(1, 0), a3, voffA);
            PG8_BAR; PG8_WAIT_L(0); PG8_MMA(1, 0, At, B0); PG8_BAR; PG8_SCHED;
            PG8_STAGE(PG8_SB(1, 1), b3 + bhstep, voffB);
            PG8_WAIT_V(6); PG8_BAR; PG8_MMA(1, 1, At, B1); PG8_BAR;
            }
        }
        if constexpr (ALIGN_EPI) { if (wr == 0) PG8_BAR; }
        if constexpr (!Epi::AFTER_DRAIN) { E(acc, cur, wr, wc, fr, fq); S.done(cur); }
        if constexpr (Sched::HAS_SIG) pend = cur.pm;
        if (!has_next) break;
        if constexpr (!SP2) {
#pragma unroll
        for (int a = 0; a < 2; ++a)
#pragma unroll
            for (int b = 0; b < 2; ++b)
#pragma unroll
                for (int m = 0; m < 4; ++m)
#pragma unroll
                    for (int n = 0; n < 2; ++n) acc[a][b][m][n] = (f32x4){0.f, 0.f, 0.f, 0.f};
        }
        cur = nxt; cA = nA; cB = nB; ++ui;
        if constexpr (ALIGN_EPI) { if (wr == 1) PG8_BAR; }
    }
    PG8_WAIT_V(0);
    if constexpr (Sched::HAS_SIG) { if (pend >= 0) { S.signal(pend, lane); pend = -1; } }
    if constexpr (!ALIGN_EPI) { if (wr == 0) PG8_BAR; }
    PG8_BAR;
    if constexpr (Epi::AFTER_DRAIN) { E.fused(acc, cur, wr, wc, fr, fq, lds, wid, lane); S.done(cur); }
#undef PG8_SA
#undef PG8_SB
#undef PG8_STAGE
#undef PG8_LDA
#undef PG8_LDB
#undef PG8_MMA
#undef PG8_WAIT_V
#undef PG8_ZERO
#undef PG8_WAIT_L
#undef PG8_BAR
#undef PG8_SCHED
}
}
#define GAS __attribute__((address_space(1)))
#define LAS __attribute__((address_space(3)))
typedef unsigned short bf16;
typedef unsigned v4u __attribute__((ext_vector_type(4)));
typedef float f32x4 __attribute__((ext_vector_type(4)));
typedef short bf16x8 __attribute__((ext_vector_type(8)));
typedef GAS unsigned gu32;
typedef GAS unsigned long long gu64;
#define RLX_AGENT __ATOMIC_RELAXED, __HIP_MEMORY_SCOPE_AGENT
#define LDS_WAIT() asm volatile("s_waitcnt lgkmcnt(0)" ::: "memory")
#define VM_WAIT() asm volatile("s_waitcnt vmcnt(0)" ::: "memory")
__device__ __forceinline__ unsigned long long rt() { return __builtin_amdgcn_s_memrealtime(); }
__device__ __forceinline__ unsigned f2bf(float f) { unsigned u = __builtin_bit_cast(unsigned, f); return (u + 0x7fffu + ((u >> 16) & 1u)) >> 16; }
__device__ __forceinline__ unsigned pk2(float lo, float hi) { return f2bf(lo) | (f2bf(hi) << 16); }

#define XB_TMO      128
#define XB_XCNT(j)  (256  + 64 * (j))
#define XB_XSUB(j)  (1280 + 64 * (j))
#define XB_XGEN(j)  (2304 + 64 * (j))
#define XB_TOP      3328
#define XB_TOPGEN   3392
#define XCD_BAR_WORDS 3456
#define XB_SPIN_CAP (1u << 18)

__device__ __forceinline__ unsigned xb_ld(unsigned* p)              { return __hip_atomic_load(p, __ATOMIC_RELAXED, __HIP_MEMORY_SCOPE_AGENT); }
__device__ __forceinline__ unsigned xb_add(unsigned* p, unsigned v) { return __hip_atomic_fetch_add(p, v, __ATOMIC_RELAXED, __HIP_MEMORY_SCOPE_AGENT); }
__device__ __forceinline__ unsigned xb_xcc_id() { return (unsigned)__builtin_amdgcn_s_getreg((3 << 11) | 20) & 0xFu; }
#define XB_SPIN(cond, bar) do { unsigned _sp = 0; while (cond) { __builtin_amdgcn_s_sleep(1); \
    if ((++_sp & 255u) == 0u) { if (xb_ld(&(bar)[XB_TMO])) break; if (_sp > XB_SPIN_CAP) { atomicAdd(&(bar)[XB_TMO], 1u); break; } } } } while (0)

struct XcdBarrier {
    unsigned* bar; unsigned x;
    volatile LAS unsigned* st;
};

__device__ __forceinline__ XcdBarrier xcd_barrier_post(unsigned* bar, volatile LAS unsigned* st) {
    XcdBarrier b; b.bar = bar; b.x = xb_xcc_id(); b.st = st;
    if (threadIdx.x == 0) (void)xb_add(&bar[XB_XCNT(b.x)], 1u);
    return b;
}
__device__ __forceinline__ void xcd_barrier_complete(unsigned* bar, unsigned x, unsigned& nloc, unsigned& nx) {
    const unsigned G = gridDim.x * gridDim.y * gridDim.z;
    unsigned sum, cnt, mine, sp = 0u;
    for (;;) {
        sum = 0u; cnt = 0u; mine = 0u;
#pragma unroll
        for (unsigned j = 0; j < 16; ++j) { const unsigned c = xb_ld(&bar[XB_XCNT(j)]); sum += c; cnt += (c > 0u) ? 1u : 0u; mine = (j == x) ? c : mine; }
        if (sum == G) break;
        __builtin_amdgcn_s_sleep(1);
        if ((++sp & 255u) == 0u) { if (xb_ld(&bar[XB_TMO])) break; if (sp > XB_SPIN_CAP) { atomicAdd(&bar[XB_TMO], 1u); break; } }
    }
    nloc = mine > 0u ? mine : 1u; nx = cnt > 0u ? cnt : 1u;
}

__device__ __forceinline__ void xcd_barrier(const XcdBarrier& b) {
    asm volatile("s_waitcnt vmcnt(0)" ::: "memory");
    __syncthreads();
    if (threadIdx.x == 0) {
        unsigned* bar = b.bar;
        __builtin_amdgcn_s_waitcnt(0);
        unsigned nloc = b.st[0], nx = b.st[1];
        if (nloc == 0u) { xcd_barrier_complete(bar, b.x, nloc, nx); b.st[0] = nloc; b.st[1] = nx; }
        const unsigned old = xb_add(&bar[XB_XSUB(b.x)], 1u);
        const unsigned gen = old / nloc;
        if (old + 1u == (gen + 1u) * nloc) {
            __builtin_amdgcn_fence(__ATOMIC_RELEASE, "agent");
            asm volatile("s_waitcnt vmcnt(0)" ::: "memory");
            const unsigned og = xb_add(&bar[XB_TOP], 1u);
            const unsigned tg = og / nx;
            if (og + 1u == (tg + 1u) * nx) xb_add(&bar[XB_TOPGEN], 1u);
            else XB_SPIN(xb_ld(&bar[XB_TOPGEN]) == tg, bar);
            __builtin_amdgcn_fence(__ATOMIC_ACQUIRE, "agent");
            xb_add(&bar[XB_XGEN(b.x)], 1u);
            asm volatile("s_waitcnt vmcnt(0)" ::: "memory");
        } else {
            XB_SPIN(xb_ld(&bar[XB_XGEN(b.x)]) == gen, bar);
            __builtin_amdgcn_fence(__ATOMIC_ACQUIRE, "agent");
            asm volatile("s_waitcnt vmcnt(0)" ::: "memory");
        }
    }
    __syncthreads();
}
using pg8::bf_lo; using pg8::bf_hi;
constexpr int DM = 1024, MP = 8 * 4096, MS = 32 * 16, MT = MP + MS;
constexpr int DFF = 2816, DIN = 3584, MMEM = 8 * 256, NKV = 40;
constexpr size_t OFF_Y = 0, OFF_POOLP = (size_t)MT * DM, OFF_POOLS = OFF_POOLP + 8 * 15 * 512, OFF_SGUV = OFF_POOLS + 32 * 15 * 512,
                 OFF_MK = OFF_SGUV + 32 * 16 * 512, OFF_MV = OFF_MK + (size_t)MMEM * DM, OUT_TOTAL = OFF_MV + (size_t)MMEM * DM;
constexpr int NWAVES = 8;
#ifndef MK_PER_PHASE
#define MK_PER_PHASE 0
#endif
constexpr int N_PHASES = 15;

constexpr size_t al256(size_t x) { return (x + 255) & ~(size_t)255; }
constexpr size_t WS_CTL = 0, CTL_ZERO_BYTES = 1u << 20;
constexpr size_t WS_W13A = CTL_ZERO_BYTES;
constexpr size_t WS_W2A  = WS_W13A + al256((size_t)2 * DFF * DM * 2);
constexpr size_t WS_WIN  = WS_W2A  + al256((size_t)DM * DFF * 2);
constexpr size_t WS_WA   = WS_WIN  + al256((size_t)DIN * DM * 2);
constexpr size_t WS_WPB  = WS_WA   + al256((size_t)DM * 512 * 2);
constexpr size_t WS_WO   = WS_WPB  + al256((size_t)DM * 512 * 2);
constexpr size_t WS_WMKV = WS_WO   + al256((size_t)DM * DM * 2);
constexpr size_t WS_WQ   = WS_WMKV + al256((size_t)2 * DM * DM * 2);
constexpr size_t WS_WCO  = WS_WQ   + al256((size_t)DM * DM * 2);
constexpr size_t WS_W13B = WS_WCO  + al256((size_t)DM * DM * 2);
constexpr size_t WS_W2B  = WS_W13B + al256((size_t)2 * DFF * DM * 2);
constexpr size_t WS_WSP  = WS_W2B  + al256((size_t)DM * DFF * 2);
constexpr size_t WS_WSS  = WS_WSP  + al256((size_t)4 * 128 * 128 * 2);
constexpr size_t WS_HB   = WS_WSS  + al256((size_t)4 * 128 * 128 * 2);
constexpr size_t WS_MEMN = WS_HB   + al256((size_t)MT * DM * 2);
constexpr size_t WS_KB   = WS_MEMN + al256((size_t)MMEM * DM * 2);
constexpr size_t WS_VT   = WS_KB   + al256((size_t)NKV * 256 * DM * 2);
constexpr size_t WS_ST0  = WS_VT   + al256((size_t)NKV * 256 * DM * 2);
constexpr size_t WS_ST1  = WS_ST0  + al256((size_t)MT * 64);
constexpr size_t WS_ST2  = WS_ST1  + al256((size_t)MT * 64);
constexpr size_t WS_ST3  = WS_ST2  + al256((size_t)MT * 64);
constexpr size_t WS_STV  = WS_ST3  + al256((size_t)MT * 64);
constexpr size_t WS_RACT = WS_STV  + al256((size_t)MT * 64);
constexpr size_t WS_GATE = WS_RACT, WS_DD = WS_GATE + (size_t)MT * 2048 * 2;
constexpr size_t WS_RZ   = WS_RACT + al256((size_t)MT * DFF * 2);
constexpr size_t WS_XA = WS_RZ, WS_UU = WS_XA + (size_t)MT * 512 * 2, WS_VV = WS_UU + (size_t)MT * 512 * 2, WS_US = WS_VV + (size_t)MT * 512 * 2;
constexpr size_t WS_MRG = WS_RZ, WS_QB = WS_RZ, WS_OB = WS_RZ + (size_t)MT * DM * 2;
constexpr size_t WS_END = WS_RZ + al256((size_t)MT * 2048 * 2);
static_assert(WS_DD + (size_t)MT * 512 * 2 <= WS_RZ, "gate | dd fit in the act region");
static_assert(WS_END <= (size_t)512 * 1024 * 1024, "d_ws map fits 512 MiB");
constexpr int CW_BAR = 4096, CW_XCC = 8192, CW_Q1 = 12288, CW_Q2 = 12352, CW_QF = 12416  , CW_DEP = 16384;
static_assert((CW_DEP + 8 * 136 * 64) * 4 <= (int)CTL_ZERO_BYTES, "CTL words inside the memset region");

constexpr int RING_BYTES = 131072, LDS_BYTES = 163840, LDSCTL_OFF = LDS_BYTES - 1024, MISC_OFF = LDSCTL_OFF + 320;

__device__ __forceinline__ float wave_sum(float v) {
#pragma unroll
    for (int o = 1; o < 64; o <<= 1) v += __shfl_xor(v, o);
    return v;
}
template <bool BLK = true>
__device__ __forceinline__ void transpose_item(const float* W, int ldn, int k0, int n0, const float* gain, bf16* WT, int ldk, int drow0, LAS float* scr, int lane) {
    f32x4 tv[16];
    const int r = lane >> 4, c4 = (lane & 15) * 4;
#pragma unroll
    for (int i = 0; i < 16; ++i) tv[i] = __builtin_nontemporal_load((const f32x4*)(W + (size_t)(k0 + 4 * i + r) * ldn + n0 + c4));
    if (gain) {
#pragma unroll
        for (int i = 0; i < 16; ++i) tv[i] = tv[i] * gain[k0 + 4 * i + r]; }
#pragma unroll
    for (int i = 0; i < 16; ++i) { LAS float* d = scr + (4 * i + r) * 65 + c4; d[0] = tv[i].x; d[1] = tv[i].y; d[2] = tv[i].z; d[3] = tv[i].w; }
    LDS_WAIT(); asm volatile("" ::: "memory");
    const int c = lane & 7;
#pragma unroll
    for (int j = 0; j < 8; ++j) { const int n = (lane >> 3) + 8 * j; const LAS float* sp = scr + (8 * c) * 65 + n;
        v4u o; o.x = pk2(sp[0 * 65], sp[1 * 65]); o.y = pk2(sp[2 * 65], sp[3 * 65]); o.z = pk2(sp[4 * 65], sp[5 * 65]); o.w = pk2(sp[6 * 65], sp[7 * 65]);
        const int drow = drow0 + n;
        bf16* dp = BLK ? (bf16*)((unsigned char*)WT + (size_t)((drow >> 8) * (ldk >> 6) + (k0 >> 6)) * 32768 + pg8::img_off_w(drow & 255, 8 * c)) : WT + (size_t)drow * ldk + k0 + 8 * c;
        *(v4u*)dp = o; }
    LDS_WAIT(); asm volatile("" ::: "memory");
}
constexpr int TR_SCR_BYTES = 64 * 65 * 4;

struct Args { const float* in[32]; float* out; unsigned char* ws; int ph_lo, ph_hi; };

template <int PART>
__device__ __forceinline__ void phase_prep(const Args& A, LAS unsigned char* lds, int tid, int wave, int lane, int wgi, int nwg, unsigned* queue) {
    unsigned char* ws = A.ws;
    LAS float* scr = (LAS float*)(lds + wave * TR_SCR_BYTES);
    const int gw = wgi * NWAVES + wave, NGW = nwg * NWAVES;
    for (int pass = 0; pass < (PART == 0 ? 2 : 1); ++pass) {
    const bool do_ab = (PART != 0) || ((pass == 0) == ((wave & 1) == 0));
    if (do_ab) {
    constexpr int I_W1 = (DM / 64) * (DFF / 64), I_W2 = (DFF / 64) * (DM / 64), I_PB = (512 / 64) * (DM / 64), I_SQ = (DM / 64) * (DM / 64), I_VT = 32 * (256 / 64) * (DM / 64);
    constexpr int I_WINA = (DM / 64) * 24, I_WINB = (DM / 64) * 32;
    constexpr int VT1 = 23 * 64, VT2 = I_VT - VT1, I_PVT = 8 * 64;
    constexpr int NITEMS = PART == 0 ? 2 * I_W1 + I_W2 + I_WINA + 2 * I_SQ : (PART == 1 ? I_PB + 2 * I_SQ + I_WINB + VT1 : VT2 + I_PVT + 2 * I_W1 + I_W2 + I_SQ);
    constexpr int ROW0 = PART == 0 ? 0 : MT + MMEM, NROWS = PART == 0 ? MT + MMEM : (PART == 1 ? MT + MMEM : MT + MMEM + 32 * 256);
    constexpr int NWORK = NITEMS + (NROWS - ROW0) / 4;
    static_assert(MP % 4 == 0 && MT % 4 == 0 && MMEM % 4 == 0, "row items must not straddle kinds");
    const bool dyn = queue != nullptr;
    volatile LAS unsigned* qslot = (volatile LAS unsigned*)(lds + MISC_OFF) + 16;
    unsigned nextq = 0; if (dyn && tid == 0) nextq = __hip_atomic_fetch_add(queue, (unsigned)NWAVES, RLX_AGENT);
    int w = gw;
    for (;;) {
        if (dyn) { if (tid == 0) *qslot = nextq; __syncthreads(); const int base = (int)*qslot; __syncthreads(); if (base >= NWORK) break;
            if (tid == 0) nextq = __hip_atomic_fetch_add(queue, (unsigned)NWAVES, RLX_AGENT); w = base + wave; }
        if (w >= NWORK) { if (dyn) continue; else break; }
        if (w < NITEMS) {
        int r = w;
        do {
#define W13_ITEM(SRC, GAIN, DST, HALFSEL) if (r < I_W1) { const int nblk = DFF / 64, kb = r / nblk, nb = r % nblk, n0 = 64 * nb; \
            transpose_item(SRC, DFF, 64 * kb, n0, GAIN, (bf16*)(ws + DST), DM, (n0 >> 7) * 256 + HALFSEL * 128 + (n0 & 127), scr, lane); break; } r -= I_W1;
#define PLAIN_ITEM(SRC, KK, NN, GAIN, DST, ROWOFF, CNT) if (r < CNT) { const int nblk = NN / 64, kb = r / nblk, nb = r % nblk; \
            transpose_item(SRC, NN, 64 * kb, 64 * nb, GAIN, (bf16*)(ws + DST), KK, ROWOFF + 64 * nb, scr, lane); break; } r -= CNT;
#define VT_ITEM(FIRST, CNT) if (r < CNT) { const int q = r + FIRST, b = q / 64, rr = q % 64, kb = rr / 16, nb = rr % 16; \
            transpose_item<false>(A.in[4] + (size_t)b * 256 * DM, DM, 64 * kb, 64 * nb, nullptr, (bf16*)(ws + WS_VT) + (size_t)(8 + b) * DM * 256, 256, 64 * nb, scr, lane); break; } r -= CNT;
#define WIN_ITEM(NB0, NBC, CNT) if (r < CNT) { const int kb = r / NBC, nb = NB0 + r % NBC; \
            transpose_item(A.in[11], DIN, 64 * kb, 64 * nb, A.in[10], (bf16*)(ws + WS_WIN), DM, 64 * nb, scr, lane); break; } r -= CNT;
#define PVT_ITEM() if (r < I_PVT) { const int b = r / 64, rr = r % 64, kb = rr / 16, nb = rr % 16; \
            transpose_item<false>(A.out + OFF_MV + (size_t)b * 256 * DM, DM, 64 * kb, 64 * nb, nullptr, (bf16*)(ws + WS_VT) + (size_t)b * DM * 256, 256, 64 * nb, scr, lane); break; } r -= I_PVT;
        if constexpr (PART == 0) {
            W13_ITEM(A.in[7], A.in[6], WS_W13A, 0)
            W13_ITEM(A.in[8], A.in[6], WS_W13A, 1)
            PLAIN_ITEM(A.in[9], DFF, DM, nullptr, WS_W2A, 0, I_W2)
            WIN_ITEM(0, 24, I_WINA)
            PLAIN_ITEM(A.in[22], DM, DM, nullptr, WS_WMKV, 0, I_SQ)
            PLAIN_ITEM(A.in[23], DM, DM, nullptr, WS_WMKV, 1024, I_SQ)
        } else if constexpr (PART == 1) {
            PLAIN_ITEM(A.in[19], 512, DM, nullptr, WS_WPB, 0, I_PB)
            PLAIN_ITEM(A.in[20], DM, DM, nullptr, WS_WO, 0, I_SQ)
            PLAIN_ITEM(A.in[25], DM, DM, A.in[24], WS_WQ, 0, I_SQ)
            WIN_ITEM(24, 32, I_WINB)
            VT_ITEM(0, VT1)
        } else {
            VT_ITEM(VT1, VT2)
            PVT_ITEM()
            W13_ITEM(A.in[28], A.in[27], WS_W13B, 0)
            W13_ITEM(A.in[29], A.in[27], WS_W13B, 1)
            PLAIN_ITEM(A.in[30], DFF, DM, nullptr, WS_W2B, 0, I_W2)
            PLAIN_ITEM(A.in[26], DM, DM, nullptr, WS_WCO, 0, I_SQ)
        }
#undef W13_ITEM
#undef PLAIN_ITEM
#undef VT_ITEM
#undef WIN_ITEM
#undef PVT_ITEM
        } while (false);
        } else if constexpr (PART != 1) {
            const int r0 = ROW0 + 4 * (w - NITEMS);
            int kind; const float* src; bf16* dst;
            if (r0 < MT) { kind = 0; src = (r0 < MP) ? A.in[0] + (size_t)r0 * DM : A.in[1] + (size_t)(r0 - MP) * DM; dst = (bf16*)(ws + WS_HB) + (size_t)r0 * DM; }
            else if (r0 < MT + MMEM) { kind = 1; src = A.in[5] + (size_t)(r0 - MT) * DM; dst = (bf16*)(ws + WS_MEMN) + (size_t)(r0 - MT) * DM; }
            else { kind = 2; src = A.in[3] + (size_t)(r0 - MT - MMEM) * DM; dst = (bf16*)(ws + WS_KB) + (size_t)(8 * 256 + (r0 - MT - MMEM)) * DM; }
            f32x4 v[4][4];
#pragma unroll
            for (int h = 0; h < 4; ++h)
#pragma unroll
                for (int j = 0; j < 4; ++j) v[h][j] = __builtin_nontemporal_load((const f32x4*)(src + (size_t)h * DM) + lane + 64 * j);
#pragma unroll
            for (int h = 0; h < 4; ++h) { const int rr = r0 + h;
                float s = 0.f;
#pragma unroll
                for (int j = 0; j < 4; ++j) s += (v[h][j].x * v[h][j].x + v[h][j].y * v[h][j].y) + (v[h][j].z * v[h][j].z + v[h][j].w * v[h][j].w);
                if (kind != 2) s = wave_sum(s);
                if (kind == 0) { float* st = (float*)(ws + WS_ST0) + (size_t)rr * 16; if (lane < 16) st[lane] = (lane == 0) ? s : 0.f; }
                if (kind == 1) { const float rin = 1.0f / sqrtf(s * (1.0f / DM) + 1e-6f); const f32x4* gr = (const f32x4*)A.in[21] + lane;
#pragma unroll
                    for (int j = 0; j < 4; ++j) v[h][j] = v[h][j] * rin * gr[64 * j]; }
                unsigned long long* o8 = (unsigned long long*)(dst + (size_t)h * DM) + lane;
#pragma unroll
                for (int j = 0; j < 4; ++j) { const unsigned long long ov = (unsigned long long)pk2(v[h][j].x, v[h][j].y) | ((unsigned long long)pk2(v[h][j].z, v[h][j].w) << 32);
                    if (kind == 0) *(unsigned long long*)(ws + WS_HB + pg8::hb_byte(rr, 4 * (lane + 64 * j))) = ov;
                    else if (kind == 1) *(unsigned long long*)(ws + WS_MEMN + pg8::hb_byte(rr - MT, 4 * (lane + 64 * j))) = ov; else o8[64 * j] = ov; } }
        }
        if (!dyn) w += NGW;
    }
    } else {
    if constexpr (PART == 0) {
    const int gt = wgi * (NWAVES * 64) + tid, NGT = nwg * NWAVES * 64;
    for (int idx = gt; idx < 512 * 256; idx += NGT) {
        const int k = idx >> 8, n4 = (idx & 255) * 4, g = k >> 7;
        const float* wp = A.in[13] + (size_t)k * 128; const float* ps = A.in[14] + g * 128; const float* pa = A.in[18] + (size_t)(g * 128) * DM + n4;
        f32x4 acc = (f32x4){0.f, 0.f, 0.f, 0.f};
#pragma unroll 16
        for (int d = 0; d < 128; ++d) { const float c = wp[d] * ps[d]; acc += *(const f32x4*)(pa + (size_t)d * DM) * c; }
        unsigned char* ob = ws + WS_WA + (size_t)((n4 >> 8) * 8 + (k >> 6)) * 32768;
        *(bf16*)(ob + pg8::img_off_w((n4 & 255) + 0, k & 63)) = (bf16)f2bf(acc.x); *(bf16*)(ob + pg8::img_off_w((n4 & 255) + 1, k & 63)) = (bf16)f2bf(acc.y);
        *(bf16*)(ob + pg8::img_off_w((n4 & 255) + 2, k & 63)) = (bf16)f2bf(acc.z); *(bf16*)(ob + pg8::img_off_w((n4 & 255) + 3, k & 63)) = (bf16)f2bf(acc.w);
    }
    for (int idx = gt; idx < 2 * 65536; idx += NGT) {
        const int smp = idx >> 16, h = (idx >> 14) & 3, p = (idx >> 7) & 127, q = idx & 127;
        float w;
        if (!smp) w = ((p >> 6) >= (q >> 6)) ? A.in[16][(size_t)(h * 128 + p) * 128 + q] : 0.f;
        else w = ((p >> 4) == (q >> 4)) ? A.in[16][(size_t)(h * 128 + (p & 15)) * 128 + (q & 15)] : 0.f;
        ((bf16*)(ws + (smp ? WS_WSS : WS_WSP)))[(size_t)(h * 128 + p) * 128 + q] = (bf16)f2bf(w);
    }
    }
    }
    }
}

__device__ __forceinline__ void phase_mixprep(const Args& A, LAS unsigned char* lds, int tid, int wave, int lane, int vcu, int G) {
    unsigned char* ws = A.ws;
    const int gw = vcu * NWAVES + wave, NGW = G * NWAVES;
    {
        const bf16* xa = (const bf16*)(ws + WS_XA); bf16* dd = (bf16*)(ws + WS_DD);
        const int cg = lane, w = 2 << (cg >> 4);
        const int pgw = (G == 256) ? (vcu >= 16 ? (vcu - 16) * NWAVES + wave : MT) : gw, pngw = (G == 256) ? 240 * NWAVES : NGW;
        for (int rr = pgw; rr < MT / 16; rr += pngw) {
            const int row0 = rr * 16; const bool smp = row0 >= MP;
            const int t0 = smp ? 0 : (row0 & 4095);
            const bf16* xp = xa + (size_t)row0 * 512 + cg * 8;
            v4u X[31];
#pragma unroll
            for (int i = 0; i < 16; ++i) X[15 + i] = *(const v4u*)(xp + i * 512);
            if (smp) {
                const float* stp = A.in[2] + (size_t)((row0 - MP) >> 4) * 15 * 512 + cg * 8;
#pragma unroll
                for (int j = 1; j < 16; ++j) { const f32x4 a = *(const f32x4*)(stp + (15 - j) * 512), b = *(const f32x4*)(stp + (15 - j) * 512 + 4);
                    v4u p; p.x = pk2(a.x, a.y); p.y = pk2(a.z, a.w); p.z = pk2(b.x, b.y); p.w = pk2(b.z, b.w); X[15 - j] = p; }
            } else {
#pragma unroll
                for (int j = 1; j < 16; ++j) { const bool ok = t0 - j >= 0; const v4u x = *(const v4u*)(xp - (ok ? j : 0) * 512); X[15 - j] = ok ? x : (v4u){0u, 0u, 0u, 0u}; }
            }
            float s[8];
#pragma unroll
            for (int j = 0; j < 8; ++j) s[j] = 0.f;
#pragma unroll
            for (int j = 1; j < 16; ++j) { const float mk = (j < w) ? 1.0f : 0.0f; const v4u x = X[15 - j];
                s[0] += mk * bf_lo(x.x); s[1] += mk * bf_hi(x.x); s[2] += mk * bf_lo(x.y); s[3] += mk * bf_hi(x.y); s[4] += mk * bf_lo(x.z); s[5] += mk * bf_hi(x.z); s[6] += mk * bf_lo(x.w); s[7] += mk * bf_hi(x.w); }
#pragma unroll
            for (int i = 0; i < 16; ++i) {
                const v4u x = X[15 + i];
                s[0] += bf_lo(x.x); s[1] += bf_hi(x.x); s[2] += bf_lo(x.y); s[3] += bf_hi(x.y); s[4] += bf_lo(x.z); s[5] += bf_hi(x.z); s[6] += bf_lo(x.w); s[7] += bf_hi(x.w);
                const int nv = smp ? w : ((t0 + i + 1 < w) ? t0 + i + 1 : w);
                const float ic = 1.0f / (float)nv;
                v4u o; o.x = pk2(s[0] * ic - bf_lo(x.x), s[1] * ic - bf_hi(x.x)); o.y = pk2(s[2] * ic - bf_lo(x.y), s[3] * ic - bf_hi(x.y)); o.z = pk2(s[4] * ic - bf_lo(x.z), s[5] * ic - bf_hi(x.z)); o.w = pk2(s[6] * ic - bf_lo(x.w), s[7] * ic - bf_hi(x.w));
                *(v4u*)((unsigned char*)dd + pg8::k512_byte(row0 + i, cg * 8)) = o;
                const v4u y2 = X[14 + i], y4 = X[12 + i], y8 = X[8 + i], y16 = X[i];
                v4u y; y.x = (w == 2) ? y2.x : (w == 4) ? y4.x : (w == 8) ? y8.x : y16.x; y.y = (w == 2) ? y2.y : (w == 4) ? y4.y : (w == 8) ? y8.y : y16.y;
                y.z = (w == 2) ? y2.z : (w == 4) ? y4.z : (w == 8) ? y8.z : y16.z; y.w = (w == 2) ? y2.w : (w == 4) ? y4.w : (w == 8) ? y8.w : y16.w;
                s[0] -= bf_lo(y.x); s[1] -= bf_hi(y.x); s[2] -= bf_lo(y.y); s[3] -= bf_hi(y.y); s[4] -= bf_lo(y.z); s[5] -= bf_hi(y.z); s[6] -= bf_lo(y.w); s[7] -= bf_hi(y.w);
            }
        }
    }
    __syncthreads();
    {
        const bf16* vv = (const bf16*)(ws + WS_VV); const bf16* uu = (const bf16*)(ws + WS_UU); bf16* us = (bf16*)(ws + WS_US);
        const float* stv = (const float*)(ws + WS_STV);
        LAS bf16* VT = (LAS bf16*)lds;
        const int fr = lane & 15, fq = lane >> 4;
        for (int un = vcu; un < (MT / 128) * 4; un += G) {
            const int ci = un >> 2, hd = un & 3, row0 = ci * 128; const bool smp = row0 >= MP;
            const bf16* wsel = (const bf16*)(ws + (smp ? WS_WSS : WS_WSP)) + (size_t)hd * 128 * 128;
            const int p = wave * 16 + fr, prow = row0 + p;
            bf16x8 wf[4];
#pragma unroll
            for (int ks = 0; ks < 4; ++ks) wf[ks] = *(const bf16x8*)(wsel + (size_t)p * 128 + ks * 32 + 8 * fq);
            unsigned long long ur[8];
#pragma unroll
            for (int nt = 0; nt < 8; ++nt) ur[nt] = __builtin_nontemporal_load((const unsigned long long*)(uu + (size_t)prow * 512 + hd * 128 + nt * 16 + 4 * fq));
            const f32x4 g0 = *(const f32x4*)(A.in[15] + hd * 128 + (tid & 15) * 8), g1 = *(const f32x4*)(A.in[15] + hd * 128 + (tid & 15) * 8 + 4);
#pragma unroll
            for (int it = 0; it < 4; ++it) {
                const int idx = it * 512 + tid, q = idx >> 4, c8 = idx & 15, row = row0 + q;
                const v4u raw = __builtin_nontemporal_load((const v4u*)(vv + (size_t)row * 512 + hd * 128 + c8 * 8));
                const f32x4* sp = (const f32x4*)(stv + (size_t)row * 16); const f32x4 a = sp[0], b = sp[1], c = sp[2], d = sp[3];
                const float sum = ((a.x + a.z) + (b.x + b.z)) + ((c.x + c.z) + (d.x + d.z)), sq = ((a.y + a.w) + (b.y + b.w)) + ((c.y + c.w) + (d.y + d.w));
                const float mu = sum * (1.0f / 512.0f); float var = sq * (1.0f / 512.0f) - mu * mu; var = var > 0.f ? var : 0.f;
                const float rs = 1.0f / sqrtf(var + 1e-6f);
                float x[8];
                x[0] = (bf_lo(raw.x) - mu) * rs * g0.x; x[1] = (bf_hi(raw.x) - mu) * rs * g0.y; x[2] = (bf_lo(raw.y) - mu) * rs * g0.z; x[3] = (bf_hi(raw.y) - mu) * rs * g0.w;
                x[4] = (bf_lo(raw.z) - mu) * rs * g1.x; x[5] = (bf_hi(raw.z) - mu) * rs * g1.y; x[6] = (bf_lo(raw.w) - mu) * rs * g1.z; x[7] = (bf_hi(raw.w) - mu) * rs * g1.w;
                if (smp) { float* dst = A.out + OFF_SGUV + (size_t)(row - MP) * 512 + hd * 128 + c8 * 8; *(f32x4*)dst = (f32x4){x[0], x[1], x[2], x[3]}; *(f32x4*)(dst + 4) = (f32x4){x[4], x[5], x[6], x[7]}; }
#pragma unroll
                for (int j = 0; j < 8; ++j) VT[(c8 * 8 + j) * 136 + ((((q >> 3) ^ c8) << 3) | (q & 7))] = (bf16)f2bf(x[j]);
            }
            __syncthreads();
            f32x4 acc[8];
#pragma unroll
            for (int nt = 0; nt < 8; ++nt) acc[nt] = (f32x4){0.f, 0.f, 0.f, 0.f};
#pragma unroll
            for (int ks = 0; ks < 4; ++ks) {
#pragma unroll
                for (int nt = 0; nt < 8; ++nt) { const bf16x8 vf = *(const LAS bf16x8*)(VT + (nt * 16 + fr) * 136 + (((ks * 4 + fq) ^ (nt * 2 + (fr >> 3))) << 3));
                    acc[nt] = __builtin_amdgcn_mfma_f32_16x16x32_bf16(vf, wf[ks], acc[nt], 0, 0, 0); }
            }
            const float bias = A.in[17][hd * 128 + (smp ? fr : p)];
#pragma unroll
            for (int nt = 0; nt < 8; ++nt) { const int col = hd * 128 + nt * 16 + 4 * fq;
                const unsigned u0 = (unsigned)ur[nt], u1 = (unsigned)(ur[nt] >> 32);
                const float o0 = bf_lo(u0) * (acc[nt].x + bias), o1 = bf_hi(u0) * (acc[nt].y + bias), o2 = bf_lo(u1) * (acc[nt].z + bias), o3 = bf_hi(u1) * (acc[nt].w + bias);
                *(unsigned long long*)((unsigned char*)us + pg8::k512_byte(prow, col)) = (unsigned long long)pk2(o0, o1) | ((unsigned long long)pk2(o2, o3) << 32); }
            __syncthreads();
        }
    }
}

__device__ __forceinline__ void glds16_asm(const void* gsrc, unsigned lds_dst) {
    unsigned keep;
    asm volatile("s_mov_b32 %0, m0\n\ts_mov_b32 m0, %2\n\ts_nop 0\n\tglobal_load_lds_dwordx4 %1, off\n\ts_mov_b32 m0, %0" : "=&s"(keep) : "v"(gsrc), "s"(lds_dst) : "memory");
}
constexpr int ATT_NBUF = 5, ATT_CHB = 16384, ATT_P_OFF = ATT_NBUF * ATT_CHB, ATT_P_STRIDE = 8448, ATT_ITEMS = 1024 + 128;
static_assert(ATT_P_OFF + 8 * ATT_P_STRIDE <= LDSCTL_OFF, "attention LDS map");
__device__ __forceinline__ void phase_attention(const Args& A, LAS unsigned char* lds, int tid, int wave, int lane, int vcu, int G) {
    unsigned char* ws = A.ws;
    const bf16* qb = (const bf16*)(ws + WS_QB); const bf16* kb = (const bf16*)(ws + WS_KB); const bf16* vt = (const bf16*)(ws + WS_VT); bf16* ob = (bf16*)(ws + WS_OB);
    LAS bf16* P = (LAS bf16*)(lds + ATT_P_OFF + wave * ATT_P_STRIDE);
    const int fr = lane & 15, fq = lane >> 4;
    int srow[2], scolK[2], scolV[2];
#pragma unroll
    for (int i = 0; i < 2; ++i) { const int p = (wave * 2 + i) * 64 + lane; srow[i] = p >> 5; scolV[i] = ((p & 31) ^ (srow[i] & 15)) * 8; scolK[i] = ((p & 31) ^ ((((srow[i] >> 3) & 3) << 2) | (srow[i] & 3))) * 8; }
    const unsigned lds_base = __builtin_amdgcn_readfirstlane((unsigned)(size_t)lds);
    const int rd_off = fr * 512 + ((fq ^ fr) * 16);
    const int rdk_off = (8 * (fr >> 2) + (fr & 3)) * 512 + ((fq ^ fr) * 16);
    for (int it0 = vcu; it0 < ATT_ITEMS; it0 += G) {
        int it = it0;
        if (G == 256 && it0 < 1024) { const int rnd = it0 >> 8, pair = (vcu >> 5) * 4 + ((vcu >> 3) & 3); it = pair * 32 + (vcu & 7) + 8 * rnd; }
        int kvb, hd, rbase, nact;
        if (it < 1024) { kvb = it >> 7; hd = (it >> 5) & 3; rbase = kvb * 4096 + (it & 31) * 128; nact = 8; }
        else { const int t = it - 1024; kvb = 8 + (t >> 2); hd = t & 3; rbase = MP + (t >> 2) * 16; nact = 1; }
        const bool active = wave < nact;
        const int r0 = rbase + (active ? wave : 0) * 16;
        const bf16* gp[2];
#pragma unroll
        for (int i = 0; i < 2; ++i) gp[i] = kb + (size_t)kvb * 256 * DM + hd * 256 + (size_t)srow[i] * DM + scolK[i];
        const bf16* vsrc = vt + ((size_t)kvb * DM + hd * 256) * 256;
#define ATT_ISSUE(c) do { const unsigned dstb = lds_base + ((c) % ATT_NBUF) * ATT_CHB + wave * 2048; \
            _Pragma("unroll") for (int i = 0; i < 2; ++i) { if ((c) == 8) gp[i] = vsrc + (size_t)srow[i] * 256 + scolV[i]; \
                glds16_asm(gp[i], dstb + i * 1024); \
                gp[i] += ((c) < 8) ? 32 * DM : 32 * 256; asm volatile("" : "+v"(gp[i])); } } while (0)
#define ATT_BOUNDARY(b) do { if ((b) <= 12) asm volatile("s_waitcnt vmcnt(6)" ::: "memory"); else if ((b) == 13) asm volatile("s_waitcnt vmcnt(4)" ::: "memory"); \
            else if ((b) == 14) asm volatile("s_waitcnt vmcnt(2)" ::: "memory"); else asm volatile("s_waitcnt vmcnt(0)" ::: "memory"); \
            asm volatile("s_waitcnt lgkmcnt(0)" ::: "memory"); __builtin_amdgcn_s_barrier(); asm volatile("" ::: "memory"); \
            if ((b) + 4 < 16) ATT_ISSUE((b) + 4); } while (0)
#define ATT_LOAD(dst, c, h) do { const LAS unsigned char* _b = lds + ((c) % ATT_NBUF) * ATT_CHB + (((c) < 8) ? (h) * 2048 + rdk_off : (h) * 8192 + rd_off); \
            _Pragma("unroll") for (int ks = 0; ks < 8; ++ks) dst[ks] = *(const LAS bf16x8*)(_b + ((((c) < 8) ? rdk_off : rd_off) ^ (ks * 64)) - (((c) < 8) ? rdk_off : rd_off)); } while (0)
        ATT_ISSUE(0); ATT_ISSUE(1); ATT_ISSUE(2); ATT_ISSUE(3);
        bf16x8 qf[8];
        {
#pragma unroll
            for (int ks = 0; ks < 8; ++ks) qf[ks] = __builtin_nontemporal_load((const bf16x8*)((const unsigned char*)qb + pg8::hb_byte(r0 + fr, hd * 256 + ks * 32 + 8 * fq)));
#pragma unroll
            for (int ks = 0; ks < 8; ++ks) asm volatile("" : "+v"(qf[ks])); }
        f32x4 s[16];
#pragma unroll
        for (int nt = 0; nt < 16; ++nt) s[nt] = (f32x4){0.f, 0.f, 0.f, 0.f};
        if (!active) {
            ATT_BOUNDARY(0);
#pragma unroll
            for (int c = 0; c < 15; ++c) ATT_BOUNDARY(c + 1);
        } else {
        bf16x8 fa[8], fb[8]; float inv = 0.f;
        ATT_BOUNDARY(0);
        ATT_LOAD(fa, 0, 0);
#pragma unroll
        for (int c = 0; c < 16; ++c) {
            ATT_LOAD(fb, c, 1);
            __builtin_amdgcn_sched_barrier(0);
            if (c < 8) {
#pragma unroll
                for (int ks = 0; ks < 8; ++ks) s[c * 2] = __builtin_amdgcn_mfma_f32_16x16x32_bf16(fa[ks], qf[ks], s[c * 2], 0, 0, 0);
            } else {
                f32x4 o = (f32x4){0.f, 0.f, 0.f, 0.f};
#pragma unroll
                for (int ks = 0; ks < 8; ++ks) o = __builtin_amdgcn_mfma_f32_16x16x32_bf16(fa[ks], qf[ks], o, 0, 0, 0);
                *(LAS unsigned long long*)(P + fr * 264 + (c - 8) * 32 + 4 * fq) = (unsigned long long)pk2(o.x * inv, o.y * inv) | ((unsigned long long)pk2(o.z * inv, o.w * inv) << 32);
            }
            __builtin_amdgcn_sched_barrier(0);
            if (c < 15) { ATT_BOUNDARY(c + 1); ATT_LOAD(fa, c + 1, 0); }
            __builtin_amdgcn_sched_barrier(0);
            if (c < 8) {
#pragma unroll
                for (int ks = 0; ks < 8; ++ks) s[c * 2 + 1] = __builtin_amdgcn_mfma_f32_16x16x32_bf16(fb[ks], qf[ks], s[c * 2 + 1], 0, 0, 0);
                if (c == 7) {
                    float mx = s[0][0];
#pragma unroll
                    for (int nt = 0; nt < 16; ++nt)
#pragma unroll
                        for (int j = 0; j < 4; ++j) mx = fmaxf(mx, s[nt][j]);
                    mx = fmaxf(mx, __shfl_xor(mx, 16)); mx = fmaxf(mx, __shfl_xor(mx, 32));
                    float sm = 0.f;
#pragma unroll
                    for (int ks = 0; ks < 8; ++ks) { float pe[8];
#pragma unroll
                        for (int h = 0; h < 2; ++h)
#pragma unroll
                            for (int j = 0; j < 4; ++j) { pe[4 * h + j] = __builtin_amdgcn_exp2f(s[2 * ks + h][j] - mx); sm += pe[4 * h + j]; }
                        pg8::u32x4 w; w.x = pg8::cvt_pk_bf16(pe[0], pe[1]); w.y = pg8::cvt_pk_bf16(pe[2], pe[3]); w.z = pg8::cvt_pk_bf16(pe[4], pe[5]); w.w = pg8::cvt_pk_bf16(pe[6], pe[7]);
                        qf[ks] = __builtin_bit_cast(bf16x8, w); }
                    sm += __shfl_xor(sm, 16); sm += __shfl_xor(sm, 32); inv = 1.0f / sm;
                }
            } else {
                f32x4 o = (f32x4){0.f, 0.f, 0.f, 0.f};
#pragma unroll
                for (int ks = 0; ks < 8; ++ks) o = __builtin_amdgcn_mfma_f32_16x16x32_bf16(fb[ks], qf[ks], o, 0, 0, 0);
                *(LAS unsigned long long*)(P + fr * 264 + (c - 8) * 32 + 16 + 4 * fq) = (unsigned long long)pk2(o.x * inv, o.y * inv) | ((unsigned long long)pk2(o.z * inv, o.w * inv) << 32);
            }
            __builtin_amdgcn_sched_barrier(0);
        }
        }
        if (active) { LDS_WAIT(); asm volatile("" ::: "memory"); __builtin_amdgcn_wave_barrier();
#pragma unroll
            for (int t = 0; t < 8; ++t) { const int row = lane >> 2, c4 = lane & 3;
                const v4u w = *(const LAS v4u*)(P + row * 264 + t * 32 + c4 * 8); *(v4u*)((unsigned char*)ob + pg8::hb_byte(r0 + row, hd * 256 + t * 32 + c4 * 8)) = w; } }
        asm volatile("s_waitcnt lgkmcnt(0)" ::: "memory"); __builtin_amdgcn_s_barrier(); asm volatile("" ::: "memory");
#undef ATT_ISSUE
#undef ATT_BOUNDARY
#undef ATT_LOAD
    }
    VM_WAIT(); __syncthreads();
}

__device__ __forceinline__ void wait_panel(const unsigned* dep, int pm, unsigned need, unsigned* tmo) {
    if (threadIdx.x < 64) {
        unsigned polls = 0;
        while ((unsigned)__builtin_amdgcn_readfirstlane(__hip_atomic_load(dep + 64 * pm, RLX_AGENT)) < need) {
            if ((++polls & 1023u) == 0u) { if (__builtin_amdgcn_readfirstlane(__hip_atomic_load(tmo, RLX_AGENT)) != 0u) break;
                if (polls > (1u << 22)) { if (threadIdx.x == 0) __hip_atomic_store(tmo, 1u, RLX_AGENT); break; } }
            __builtin_amdgcn_s_sleep(2); }
        __builtin_amdgcn_fence(__ATOMIC_ACQUIRE, "agent");
        asm volatile("s_waitcnt vmcnt(0)" ::: "memory");
    }
    asm volatile("" ::: "memory"); __builtin_amdgcn_s_barrier(); asm volatile("" ::: "memory");
}
__device__ __forceinline__ void phase_final_q(const Args& A, LAS unsigned char* lds, int tid, int wave, int lane, int bx, unsigned* queues, const unsigned* dep, unsigned* tmo) {
    const bf16* hb = (const bf16*)(A.ws + WS_HB); const float* st = (const float*)(A.ws + WS_ST0);
    f32x4 g0[2], g1[2];
#pragma unroll
    for (int j = 0; j < 2; ++j) { g0[j] = *(const f32x4*)(A.in[31] + 8 * (lane + 64 * j)); g1[j] = *(const f32x4*)(A.in[31] + 8 * (lane + 64 * j) + 4); }
    volatile LAS unsigned* qslot = (volatile LAS unsigned*)(lds + MISC_OFF) + 16;
    int okpm = -1;
    for (int pass = 0; pass < 2; ++pass) {
        unsigned* q = queues + 64 * (pass == 0 ? (bx & 7) : 8);
        const int nround = pass == 0 ? 16 * 8 : 2 * 8, pm0 = pass == 0 ? 16 * (bx & 7) : 128;
        unsigned nextq = 0; if (tid == 0) nextq = __hip_atomic_fetch_add(q, 1u, RLX_AGENT);
        for (;;) {
            if (tid == 0) *qslot = nextq; __syncthreads(); const int rd = (int)*qslot; __syncthreads(); if (rd >= nround) break;
            if (tid == 0) nextq = __hip_atomic_fetch_add(q, 1u, RLX_AGENT);
            const int pm = pm0 + (rd >> 3);
            if (pm != okpm) { wait_panel(dep, pm, 32u, tmo); okpm = pm; }
            const int row0 = pm * 256 + (rd & 7) * 32 + wave * 4;
            v4u h[4][2]; f32x4 pq[4];
#pragma unroll
            for (int k = 0; k < 4; ++k) { const int r = row0 + k;
                pq[k] = *(const f32x4*)(st + (size_t)r * 16 + 4 * (lane & 3));
#pragma unroll
                for (int j = 0; j < 2; ++j) h[k][j] = __builtin_nontemporal_load((const v4u*)((const unsigned char*)hb + pg8::hb_byte(r, 8 * (lane + 64 * j)))); }
#pragma unroll
            for (int k = 0; k < 4; ++k) { const int row = row0 + k;
                float sq = (pq[k].x + pq[k].y) + (pq[k].z + pq[k].w); sq += __shfl_xor(sq, 1); sq += __shfl_xor(sq, 2);
                const float rin = __builtin_amdgcn_rsqf(sq * (1.0f / DM) + 1e-6f);
                float* yr = A.out + OFF_Y + (size_t)row * DM;
#pragma unroll
                for (int j = 0; j < 2; ++j) { const int c = 8 * (lane + 64 * j); const v4u hh = h[k][j];
                    f32x4 a, b; a.x = bf_lo(hh.x); a.y = bf_hi(hh.x); a.z = bf_lo(hh.y); a.w = bf_hi(hh.y); b.x = bf_lo(hh.z); b.y = bf_hi(hh.z); b.z = bf_lo(hh.w); b.w = bf_hi(hh.w);
                    __builtin_nontemporal_store(a * rin * g0[j], (f32x4*)(yr + c)); __builtin_nontemporal_store(b * rin * g1[j], (f32x4*)(yr + c + 4)); } }
        }
    }
}

__global__ void __launch_bounds__(NWAVES * 64, 2) fwd_kernel(Args args) {
    extern __shared__ __attribute__((aligned(16))) unsigned char lds_raw[];
    LAS unsigned char* lds = (LAS unsigned char*)lds_raw;
    volatile LAS unsigned* MISC = (volatile LAS unsigned*)(lds + MISC_OFF);
    const int tid = threadIdx.x, lane = tid & 63, wave = __builtin_amdgcn_readfirstlane(tid >> 6);
    const int G = gridDim.x; const int bx = blockIdx.x; const int vcu = (G % 8 == 0) ? (bx % 8) * (G / 8) + bx / 8 : bx;
    unsigned char* ws = args.ws;
    gu32* ctl = (gu32*)(ws + WS_CTL);
    for (int u = tid; u < (LDS_BYTES - LDSCTL_OFF) / 4; u += NWAVES * 64) ((LAS unsigned*)(lds + LDSCTL_OFF))[u] = 0u;
    __syncthreads();
    XcdBarrier bar; bar.bar = (unsigned*)(ctl + CW_BAR); bar.x = 0; bar.st = nullptr;
    if (!MK_PER_PHASE) bar = xcd_barrier_post((unsigned*)(ctl + CW_BAR), MISC + 8);
    const int lo = args.ph_lo, hi = args.ph_hi;
#ifndef PH_MASK
#define PH_MASK 0x7fff
#endif
#define IN(k) (((PH_MASK >> (k)) & 1) && lo <= (k) && (k) < hi)
#define SEAM(k) do { if (IN(k) && IN((k) + 1)) xcd_barrier(bar); } while (0)
#ifndef DF_BARRIERS
#define DF_BARRIERS 0
#endif
#define DSEAM(k) do { if (DF_BARRIERS) SEAM(k); } while (0)
    using pg8::Gemm; using pg8::StaticOrder; using pg8::DepOrder; using pg8::EpiKV; using pg8::EpiSwiglu; using pg8::EpiRes; using pg8::EpiZ; using pg8::EpiGate; using pg8::EpiQ; using pg8::gemm_phase; using pg8::bf16_t;
    float* const out = args.out;
    bf16_t* const HB = (bf16_t*)(ws + WS_HB);
    float* const ST0 = (float*)(ws + WS_ST0); float* const ST1 = (float*)(ws + WS_ST1); float* const ST2 = (float*)(ws + WS_ST2); float* const ST3 = (float*)(ws + WS_ST3);

    unsigned* const xtab = (unsigned*)(ctl + CW_XCC);
    if (tid == 0) __hip_atomic_store(xtab + bx, 0x100u | xb_xcc_id(), RLX_AGENT);
    if (IN(0)) { phase_prep<0>(args, lds, tid, wave, lane, vcu, G, nullptr); }
    SEAM(0);
    bool wtall = true;
    if (!MK_PER_PHASE && G == 256 && IN(0) && IN(1)) {
        const unsigned mine = 0x100u | xb_xcc_id();
        const unsigned other = (lane < 32) ? __hip_atomic_load(xtab + (bx & 7) + 8 * lane, RLX_AGENT) : mine;
        wtall = !__all(other == mine);
    }
    unsigned* const dctr = (unsigned*)(ctl + CW_DEP); unsigned* const tmo = (unsigned*)(ctl + 0);
#define DEPC(k) (dctr + (size_t)(k) * 136 * 64)
#define ROT(r) ((bx + G - (r)) % G)
    if (IN(2)) {
        Gemm g{HB, (const bf16_t*)(ws + WS_W13A), MT, 2 * DFF, DM, true}; DepOrder S; S.init(MT, 2 * DFF, G, ROT(0)); S.dep = nullptr; S.need = 0; S.sig = DEPC(0); S.tmo = tmo; S.skew = 1;
        EpiSwiglu E{(bf16_t*)(ws + WS_RACT), ST0, wtall};
        gemm_phase<EpiSwiglu, DepOrder, true, true>(lds, g, S, E);
    }
    DSEAM(2);
    if (IN(3)) {
        Gemm g{(const bf16_t*)(ws + WS_RACT), (const bf16_t*)(ws + WS_W2A), MT, DM, DFF, true}; DepOrder S; S.init(MT, DM, G, ROT(48)); S.dep = DEPC(0); S.need = 22 * 8; S.sig = DEPC(1); S.tmo = tmo;
        EpiRes<false> E{HB, ST1, nullptr, 0.5f, wtall};
        gemm_phase<EpiRes<false>, DepOrder, true, true>(lds, g, S, E);
        Gemm g1{(const bf16_t*)(ws + WS_MEMN), (const bf16_t*)(ws + WS_WMKV), MMEM, 2 * DM, DM, true}; StaticOrder S1; S1.init(MMEM, 2 * DM, G, (G == 256) ? ((bx >= 56 && bx < 120) ? bx - 56 : (1 << 20)) : bx);
        EpiKV E1{out + OFF_MK, out + OFF_MV, (bf16_t*)(ws + WS_KB)};
        gemm_phase<EpiKV, StaticOrder, true, true>(lds, g1, S1, E1);
    }
    DSEAM(3);
    if (IN(4)) {
        Gemm g{HB, (const bf16_t*)(ws + WS_WIN), MT, 6 * 256, DM, true}; DepOrder S; S.init(MT, 6 * 256, G, ROT(120)); S.dep = DEPC(1); S.need = 4 * 8; S.sig = nullptr; S.tmo = tmo;
        EpiZ E{ST1, (bf16_t*)(ws + WS_XA), (bf16_t*)(ws + WS_UU), (bf16_t*)(ws + WS_VV), (bf16_t*)(ws + WS_GATE), (float*)(ws + WS_STV), args.in[12], out + OFF_POOLP, out + OFF_POOLS, 0, wtall};
        gemm_phase<EpiZ, DepOrder, true, true>(lds, g, S, E);
    }
    if (IN(4)) phase_prep<1>(args, lds, tid, wave, lane, 0, 1, (unsigned*)(ctl + CW_Q1));
    SEAM(4);
    if (IN(5)) { phase_mixprep(args, lds, tid, wave, lane, vcu, G); }
    SEAM(5);
    if (IN(6)) {
        Gemm g{HB, (const bf16_t*)(ws + WS_WIN) + (size_t)6 * 256 * DM, MT, 8 * 256, DM, true}; DepOrder S; S.init(MT, 8 * 256, G, ROT(0)); S.dep = nullptr; S.need = 0; S.sig = DEPC(2); S.tmo = tmo;
        EpiZ E{ST1, (bf16_t*)(ws + WS_XA), (bf16_t*)(ws + WS_UU), (bf16_t*)(ws + WS_VV), (bf16_t*)(ws + WS_GATE), (float*)(ws + WS_STV), args.in[12], out + OFF_POOLP, out + OFF_POOLS, 6, wtall};
        gemm_phase<EpiZ, DepOrder, true, true>(lds, g, S, E);
    }
    DSEAM(6);
    if (IN(7)) {
        { Gemm g{(const bf16_t*)(ws + WS_DD), (const bf16_t*)(ws + WS_WA), MT, DM, 512, true}; DepOrder S; S.init(MT, DM, G, ROT(16)); S.dep = DEPC(2); S.need = 8 * 8; S.sig = nullptr; S.tmo = tmo;
          EpiGate<false> E{(const bf16_t*)(ws + WS_GATE), (bf16_t*)(ws + WS_MRG), wtall};
          gemm_phase<EpiGate<false>, DepOrder, true, true>(lds, g, S, E); }
        { Gemm g{(const bf16_t*)(ws + WS_US), (const bf16_t*)(ws + WS_WPB), MT, DM, 512, true}; DepOrder S; S.init(MT, DM, G, ROT(16)); S.dep = nullptr; S.need = 0; S.sig = DEPC(3); S.tmo = tmo;
          EpiGate<true> E{(const bf16_t*)(ws + WS_GATE), (bf16_t*)(ws + WS_MRG), wtall};
          gemm_phase<EpiGate<true>, DepOrder, true, true>(lds, g, S, E); }
    }
    DSEAM(7);
    if (IN(8)) {
        Gemm g{(const bf16_t*)(ws + WS_MRG), (const bf16_t*)(ws + WS_WO), MT, DM, DM, true}; DepOrder S; S.init(MT, DM, G, ROT(24)); S.dep = DEPC(3); S.need = 4 * 8; S.sig = DEPC(4); S.tmo = tmo;
        EpiRes<false> E{HB, ST2, nullptr, 1.0f, wtall};
        gemm_phase<EpiRes<false>, DepOrder, true, true>(lds, g, S, E);
    }
    DSEAM(8);
    if (IN(9)) {
        Gemm g{HB, (const bf16_t*)(ws + WS_WQ), MT, DM, DM, true}; DepOrder S; S.init(MT, DM, G, ROT(32)); S.dep = DEPC(4); S.need = 4 * 8; S.sig = nullptr; S.tmo = tmo;
        EpiQ E{ST2, (bf16_t*)(ws + WS_QB), 1.44269504089f * 0.0625f};
        gemm_phase<EpiQ, DepOrder, true, true>(lds, g, S, E);
    }
    if (IN(9)) phase_prep<2>(args, lds, tid, wave, lane, 0, 1, (unsigned*)(ctl + CW_Q2));
    SEAM(9);
    if (IN(10)) { phase_attention(args, lds, tid, wave, lane, vcu, G); }
    SEAM(10);
    if (IN(11)) {
        Gemm g{(const bf16_t*)(ws + WS_OB), (const bf16_t*)(ws + WS_WCO), MT, DM, DM, true}; DepOrder S; S.init(MT, DM, G, ROT(0)); S.dep = nullptr; S.need = 0; S.sig = DEPC(5); S.tmo = tmo;
        EpiRes<false> E{HB, ST3, nullptr, 1.0f, wtall};
        gemm_phase<EpiRes<false>, DepOrder, true, true>(lds, g, S, E);
    }
    DSEAM(11);
    if (IN(12)) {
        Gemm g{HB, (const bf16_t*)(ws + WS_W13B), MT, 2 * DFF, DM, true}; DepOrder S; S.init(MT, 2 * DFF, G, ROT(8)); S.dep = DEPC(5); S.need = 4 * 8; S.sig = DEPC(6); S.tmo = tmo; S.skew = 1;
        EpiSwiglu E{(bf16_t*)(ws + WS_RACT), ST3, wtall};
        gemm_phase<EpiSwiglu, DepOrder, true, true>(lds, g, S, E);
    }
    DSEAM(12);
    if (IN(13)) {
        Gemm g{(const bf16_t*)(ws + WS_RACT), (const bf16_t*)(ws + WS_W2B), MT, DM, DFF, true}; DepOrder S; S.init(MT, DM, G, ROT(56)); S.dep = DEPC(6); S.need = 22 * 8; S.sig = DEPC(7); S.tmo = tmo;
        EpiRes<false> E{HB, ST0, nullptr, 0.5f, wtall};
        gemm_phase<EpiRes<false>, DepOrder, true, true>(lds, g, S, E);
    }
    DSEAM(13);
    if (IN(14)) { phase_final_q(args, lds, tid, wave, lane, bx, (unsigned*)(ctl + CW_QF), DEPC(7), tmo); }
#undef DEPC
#undef ROT
#undef IN
#undef SEAM
#undef DSEAM
}

extern "C" void kernel_launch(void* const* d_in, const int* in_sizes, int n_in, void* d_out, int out_size, void* d_ws, size_t ws_size, hipStream_t stream) {
    static int grid = 0;
    if (grid == 0) {
        if (n_in != 32 || (size_t)out_size != OUT_TOTAL || ws_size < WS_END) { fprintf(stderr, "kernel_launch: unexpected shapes: n_in %d out %d ws %zu (need %zu)\n", n_in, out_size, ws_size, (size_t)WS_END); grid = -1; return; }
        int dev = 0, cus = 0, per_cu = 0;
        if (hipGetDevice(&dev) != hipSuccess || hipDeviceGetAttribute(&cus, hipDeviceAttributeMultiprocessorCount, dev) != hipSuccess) { grid = -1; return; }
        if (hipFuncSetAttribute((const void*)fwd_kernel, hipFuncAttributeMaxDynamicSharedMemorySize, LDS_BYTES) != hipSuccess) { fprintf(stderr, "kernel_launch: hipFuncSetAttribute failed\n"); grid = -1; return; }
        if (hipOccupancyMaxActiveBlocksPerMultiprocessor(&per_cu, (const void*)fwd_kernel, NWAVES * 64, LDS_BYTES) != hipSuccess || per_cu < 1) { fprintf(stderr, "kernel_launch: occupancy query says %d blocks per CU\n", per_cu); grid = -1; (void)hipGetLastError(); return; }
        grid = cus;
    }
    if (grid < 0) return;
    (void)hipMemsetAsync((char*)d_ws + WS_CTL, 0, CTL_ZERO_BYTES, stream);
    Args a{};
    for (int i = 0; i < 32; ++i) a.in[i] = (const float*)d_in[i];
    a.out = (float*)d_out; a.ws = (unsigned char*)d_ws;
#if MK_PER_PHASE
    for (int p = 0; p < N_PHASES; ++p) { a.ph_lo = p; a.ph_hi = p + 1; hipLaunchKernelGGL(fwd_kernel, dim3(grid), dim3(NWAVES * 64), LDS_BYTES, stream, a); }
#else
    a.ph_lo = 0; a.ph_hi = N_PHASES;
    hipLaunchKernelGGL(fwd_kernel, dim3(grid), dim3(NWAVES * 64), LDS_BYTES, stream, a);
#endif
}
```
